# Optimizing an MI355X kernel written in HIP

```python
import math
import jax, jax.numpy as jnp
from jax import lax
import numpy as np


D_MODEL = 2048
BATCH = 4
SEQ = 4096
DEPTH = 1

N_META = 16
POOL_WINDOWS = (2, 4, 8, 16)
POOL_GROUP = 256
POOL_WIDTH = POOL_GROUP * len(POOL_WINDOWS)
MLA_HEADS = 16
Q_LORA = 512
KV_LORA = 512
QK_NOPE = 128
QK_ROPE = 64
V_DIM = 128
QK_DIM = QK_NOPE + QK_ROPE
MLA_WIDTH = MLA_HEADS * V_DIM
ROPE_THETA = 10000.0
SOFTMAX_SCALE = QK_DIM ** -0.5
D_FF = 5632
Q_BLOCK = 128
EPS = 1e-6
SPLITS = (POOL_WIDTH,
          POOL_WIDTH + Q_LORA,
          POOL_WIDTH + Q_LORA + KV_LORA,
          POOL_WIDTH + Q_LORA + KV_LORA + QK_ROPE,
          POOL_WIDTH + Q_LORA + KV_LORA + QK_ROPE + D_MODEL)
IN_COLS = POOL_WIDTH + Q_LORA + KV_LORA + QK_ROPE + 2 * D_MODEL

kernel_name = 'hybrid_pool_mla_macaron_block'


def _rmsnorm(x, gain):
    x32 = x.astype(jnp.float32)
    y = x32 * lax.rsqrt(jnp.mean(x32 * x32, axis=-1, keepdims=True) + EPS)
    return (y * gain.astype(jnp.float32)).astype(x.dtype)


def _swiglu(h, w_gu, w_down):
    g, u = jnp.split(h @ w_gu, 2, axis=-1)
    return (jax.nn.silu(g) * u) @ w_down


def _rope_tables(L, dtype):
    pos = jnp.arange(L, dtype=jnp.float32)
    inv = ROPE_THETA ** (-jnp.arange(0, QK_ROPE, 2, dtype=jnp.float32) / QK_ROPE)
    ang = pos[:, None] * inv[None, :]
    ang = jnp.concatenate([ang, ang], axis=-1)
    return jnp.cos(ang).astype(dtype), jnp.sin(ang).astype(dtype)


def _rotate(x, cos, sin):
    x1, x2 = jnp.split(x, 2, axis=-1)
    return x * cos + jnp.concatenate([-x2, x1], axis=-1) * sin


def _multiscale_pool(u, pool_w, pool_scale):
    B, L, _ = u.shape
    u32 = u.astype(jnp.float32)
    cs = jnp.concatenate([jnp.zeros_like(u32[:, :1]), jnp.cumsum(u32, axis=1)], axis=1)
    hi = jnp.arange(1, L + 1)
    outs = []
    for g, w in enumerate(POOL_WINDOWS):
        csg = cs[..., g * POOL_GROUP:(g + 1) * POOL_GROUP]
        lo = jnp.maximum(hi - w, 0)
        cnt = (hi - lo).astype(jnp.float32)[None, :, None]
        mean = (csg[:, hi] - csg[:, lo]) / cnt
        outs.append(mean - u32[..., g * POOL_GROUP:(g + 1) * POOL_GROUP])
    d = jnp.stack(outs, axis=2).astype(u.dtype)
    y = jnp.einsum('blgc,gcd->blgd', d, pool_w).reshape(B, L, POOL_WIDTH)
    return y * pool_scale


def _attend_block(q_blk, q_pos, k, v, k_pos):
    s = jnp.einsum('bqhd,bkhd->bhqk', q_blk, k, preferred_element_type=jnp.float32) * SOFTMAX_SCALE
    mask = k_pos[None, :] <= q_pos[:, None]
    s = jnp.where(mask[None, None], s, jnp.float32(-1e30))
    p = jax.nn.softmax(s, axis=-1).astype(v.dtype)
    return jnp.einsum('bhqk,bkhd->bqhd', p, v)


def _mla(c_q, c_kv, k_rope, q_a_norm, w_q_b, kv_a_norm, w_kv_b, cos, sin):
    B, L, _ = c_q.shape
    q = (_rmsnorm(c_q, q_a_norm) @ w_q_b).reshape(B, L, MLA_HEADS, QK_DIM)
    q_nope, q_pe = jnp.split(q, [QK_NOPE], axis=-1)
    q_pe = _rotate(q_pe, cos[:, None, :], sin[:, None, :])
    kv = (_rmsnorm(c_kv, kv_a_norm) @ w_kv_b).reshape(B, L, MLA_HEADS, QK_NOPE + V_DIM)
    k_nope, v = jnp.split(kv, [QK_NOPE], axis=-1)
    k_pe = _rotate(k_rope, cos, sin)
    q = jnp.concatenate([q_nope, q_pe], axis=-1)
    k = jnp.concatenate([k_nope, jnp.broadcast_to(k_pe[:, :, None, :], (B, L, MLA_HEADS, QK_ROPE))], axis=-1)
    pos = jnp.arange(L)
    o_meta = _attend_block(q[:, :N_META], pos[:N_META], k[:, :N_META], v[:, :N_META], pos[:N_META])
    n_blk = (L - N_META) // Q_BLOCK
    q_real = q[:, N_META:].reshape(B, n_blk, Q_BLOCK, MLA_HEADS, QK_DIM).transpose(1, 0, 2, 3, 4)
    pos_real = pos[N_META:].reshape(n_blk, Q_BLOCK)
    o_real = lax.map(lambda a: _attend_block(a[0], a[1], k, v, pos), (q_real, pos_real))
    o_real = o_real.transpose(1, 0, 2, 3, 4).reshape(B, L - N_META, MLA_HEADS, V_DIM)
    o = jnp.concatenate([o_meta, o_real], axis=1)
    return o.reshape(B, L, MLA_WIDTH)


def _hybrid_mixer(h, w_in, pool_w, pool_scale, w_pool_o, q_a_norm, w_q_b, kv_a_norm, w_kv_b,
                  w_mla_o, w_out, cos, sin):
    z = h @ w_in
    u_pool, c_q, c_kv, k_rope, g_pool, g_mla = jnp.split(z, SPLITS, axis=-1)
    y_pool = _multiscale_pool(u_pool, pool_w, pool_scale) @ w_pool_o
    y_mla = _mla(c_q, c_kv, k_rope, q_a_norm, w_q_b, kv_a_norm, w_kv_b, cos, sin) @ w_mla_o
    y = jax.nn.sigmoid(g_pool) * y_pool + jax.nn.sigmoid(g_mla) * y_mla
    return y @ w_out


def setup_inputs(seed: int = 0) -> dict:
    key = jax.random.key(seed)
    ks = jax.random.split(key, 32)

    def dense(k, shape, fan_in):
        return jax.random.normal(k, shape, jnp.float32) * (fan_in ** -0.5)

    def gain(k, shape):
        return 1.0 + 0.1 * jax.random.normal(k, shape, jnp.float32)

    return {
        'x': jax.random.normal(ks[0], (BATCH, SEQ, D_MODEL), jnp.float32),
        'meta_tokens': jax.random.normal(ks[1], (N_META, D_MODEL), jnp.float32),
        'norm_ffn1_pre': gain(ks[2], (DEPTH, D_MODEL)),
        'norm_ffn1_post': gain(ks[3], (DEPTH, D_MODEL)),
        'ffn1_w_gu': dense(ks[4], (DEPTH, D_MODEL, 2 * D_FF), D_MODEL),
        'ffn1_w_down': dense(ks[5], (DEPTH, D_FF, D_MODEL), D_FF),
        'norm_mix_pre': gain(ks[6], (DEPTH, D_MODEL)),
        'norm_mix_post': gain(ks[7], (DEPTH, D_MODEL)),
        'w_in': dense(ks[8], (DEPTH, D_MODEL, IN_COLS), D_MODEL),
        'pool_w': dense(ks[9], (DEPTH, len(POOL_WINDOWS), POOL_GROUP, POOL_GROUP), POOL_GROUP),
        'pool_scale': gain(ks[10], (DEPTH, POOL_WIDTH)),
        'w_pool_o': dense(ks[11], (DEPTH, POOL_WIDTH, D_MODEL), POOL_WIDTH),
        'q_a_norm': gain(ks[12], (DEPTH, Q_LORA)),
        'w_q_b': dense(ks[13], (DEPTH, Q_LORA, MLA_HEADS * QK_DIM), Q_LORA),
        'kv_a_norm': gain(ks[14], (DEPTH, KV_LORA)),
        'w_kv_b': dense(ks[15], (DEPTH, KV_LORA, MLA_HEADS * (QK_NOPE + V_DIM)), KV_LORA),
        'w_mla_o': dense(ks[16], (DEPTH, MLA_WIDTH, D_MODEL), MLA_WIDTH),
        'w_out': dense(ks[17], (DEPTH, D_MODEL, D_MODEL), D_MODEL),
        'norm_ffn2_pre': gain(ks[18], (DEPTH, D_MODEL)),
        'norm_ffn2_post': gain(ks[19], (DEPTH, D_MODEL)),
        'ffn2_w_gu': dense(ks[20], (DEPTH, D_MODEL, 2 * D_FF), D_MODEL),
        'ffn2_w_down': dense(ks[21], (DEPTH, D_FF, D_MODEL), D_FF),
    }


def reference(x, meta_tokens, norm_ffn1_pre, norm_ffn1_post, ffn1_w_gu, ffn1_w_down,
              norm_mix_pre, norm_mix_post, w_in, pool_w, pool_scale, w_pool_o,
              q_a_norm, w_q_b, kv_a_norm, w_kv_b, w_mla_o, w_out,
              norm_ffn2_pre, norm_ffn2_post, ffn2_w_gu, ffn2_w_down):
    B = x.shape[0]
    meta = jnp.broadcast_to(meta_tokens.astype(x.dtype)[None], (B, N_META, D_MODEL))
    h = jnp.concatenate([meta, x], axis=1)
    L = h.shape[1]
    cos, sin = _rope_tables(L, h.dtype)
    for i in range(DEPTH):
        h = h + 0.5 * _rmsnorm(_swiglu(_rmsnorm(h, norm_ffn1_pre[i]), ffn1_w_gu[i], ffn1_w_down[i]),
                               norm_ffn1_post[i])
        m = _hybrid_mixer(_rmsnorm(h, norm_mix_pre[i]), w_in[i], pool_w[i], pool_scale[i], w_pool_o[i],
                          q_a_norm[i], w_q_b[i], kv_a_norm[i], w_kv_b[i], w_mla_o[i], w_out[i], cos, sin)
        h = h + _rmsnorm(m, norm_mix_post[i])
        h = h + 0.5 * _rmsnorm(_swiglu(_rmsnorm(h, norm_ffn2_pre[i]), ffn2_w_gu[i], ffn2_w_down[i]),
                               norm_ffn2_post[i])
    return h[:, N_META:]
```

```cpp
#include <hip/hip_runtime.h>
#include <hip/hip_cooperative_groups.h>
#include <cstdio>
#include <cstdint>
namespace cg = cooperative_groups;

#ifndef MK_SINGLE
#define MK_SINGLE 1
#endif

#ifndef DUP_ATTN
#define DUP_ATTN 0
#endif
#ifndef DUP_SYNC
#define DUP_SYNC 0
#endif
#ifndef DUP_P1
#define DUP_P1 0
#endif
#ifndef DUP_EW
#define DUP_EW 0
#endif
#define LAS __attribute__((address_space(3)))
typedef unsigned short bf16_t;
typedef short bf16x8 __attribute__((ext_vector_type(8)));
typedef float f32x4 __attribute__((ext_vector_type(4)));
typedef float f32x16 __attribute__((ext_vector_type(16)));
typedef unsigned u32x4 __attribute__((ext_vector_type(4)));
typedef unsigned u32x2 __attribute__((ext_vector_type(2)));
typedef float f32x2 __attribute__((ext_vector_type(2)));
typedef __bf16 bf16x2_t __attribute__((ext_vector_type(2)));

constexpr int M = 16384, DM = 2048, DFF = 5632, NGU = 2 * DFF, SEQ = 4096, NB = 4, NMETA = 16, LP = 4160, NH = 16;
constexpr int QW = 3072;
constexpr float EPS = 1e-6f;
constexpr float QSCALE = 0.10411754627697264f;
constexpr int NPH = 14;

constexpr size_t MiB = 1u << 20;
constexpr size_t WS_COS = 1 * MiB, WS_SIN = 2 * MiB, WS_SSQ = 3 * MiB, WS_RSTD1 = 5 * MiB;
constexpr size_t WS_A1M = 6 * MiB, WS_ACT1M = 6 * MiB + 256 * 1024, WS_D1MP = 6 * MiB + 512 * 1024  , WS_A2M = 7 * MiB + 256 * 1024,
                 WS_ZLOM = 7 * MiB + 512 * 1024, WS_KRM = 7 * MiB + 768 * 1024, WS_CKVNM = 7 * MiB + 832 * 1024;
constexpr size_t WS_KPE = 8 * MiB;
constexpr size_t WS_WIN = 11 * MiB, WS_WKR = 35 * MiB, WS_PWS = 35 * MiB + 512 * 1024, WS_WPO = 36 * MiB, WS_WF = 40 * MiB, WS_WQB = 44 * MiB,
                 WS_WK = 47 * MiB, WS_WV = 49 * MiB, WS_WMO = 51 * MiB, WS_WOUT = 59 * MiB;
constexpr size_t WS_WGU = 67 * MiB, WS_WD = 111 * MiB;
constexpr size_t WS_DPOOL = 67 * MiB, WS_CQN = 99 * MiB, WS_CKVN = 115 * MiB;
constexpr size_t WS_A = 133 * MiB, WS_ACT = 197 * MiB, WS_D1 = 373 * MiB, WS_T = 437 * MiB;
constexpr size_t WS_ZLO = 197 * MiB;
constexpr size_t WS_KN = 133 * MiB, WS_VT = 198 * MiB, WS_Q = 263 * MiB;
constexpr size_t WS_Y = 133 * MiB, WS_MM = 197 * MiB, WS_D2 = 373 * MiB;
constexpr size_t WS_END = 501 * MiB;

constexpr int LDS_BYTES = 147456;

__device__ __forceinline__ unsigned pk2(float lo, float hi) { f32x2 v = {lo, hi}; bf16x2_t b = __builtin_convertvector(v, bf16x2_t); return __builtin_bit_cast(unsigned, b); }
__device__ __forceinline__ float bflo(unsigned u) { return __uint_as_float(u << 16); }
__device__ __forceinline__ float bfhi(unsigned u) { return __uint_as_float(u & 0xffff0000u); }
template <int CTRL> __device__ __forceinline__ float dpp_f(float v) { return __int_as_float(__builtin_amdgcn_update_dpp(0, __float_as_int(v), CTRL, 0xF, 0xF, true)); }
__device__ __forceinline__ float xsum_rows(float v) {
    { auto r = __builtin_amdgcn_permlane16_swap(__float_as_uint(v), __float_as_uint(v), false, false); v = __uint_as_float(r[0]) + __uint_as_float(r[1]); }
    { auto r = __builtin_amdgcn_permlane32_swap(__float_as_uint(v), __float_as_uint(v), false, false); v = __uint_as_float(r[0]) + __uint_as_float(r[1]); }
    return v;
}
__device__ __forceinline__ float wave_sum(float v) {
    v += dpp_f<0xB1>(v);
    v += dpp_f<0x4E>(v);
    v += dpp_f<0x141>(v);
    v += dpp_f<0x140>(v);
    return xsum_rows(v);
}
__device__ __forceinline__ float fsigmoid(float x) { return __builtin_amdgcn_rcpf(1.f + __expf(-x)); }
__device__ __forceinline__ float fsilu(float x) { return x * fsigmoid(x); }
__device__ __forceinline__ u32x4 pack8(const f32x4 a, const f32x4 b) { u32x4 w; w.x = pk2(a[0], a[1]); w.y = pk2(a[2], a[3]); w.z = pk2(b[0], b[1]); w.w = pk2(b[2], b[3]); return w; }
__device__ __forceinline__ void unpack8(const u32x4 w, float (&f)[8]) {
    f[0] = bflo(w.x); f[1] = bfhi(w.x); f[2] = bflo(w.y); f[3] = bfhi(w.y); f[4] = bflo(w.z); f[5] = bfhi(w.z); f[6] = bflo(w.w); f[7] = bfhi(w.w);
}

__device__ __forceinline__ size_t vt_idx(int b, int r, int pos) { return ((((size_t)(b * NH + (r >> 7)) * 65 + (pos >> 6)) * 128 + (r & 127)) << 6) + (pos & 63); }

namespace pg8 {
constexpr int BM = 256, BK = 64, HALF = 128, HTB = HALF * BK * 2, STAGE_BYTES = 8 * HTB, NXCD = 8, WGM = 4;
__host__ __device__ __forceinline__ int lds_byte(int r, int c) { const int st = (r >> 4) * 2 + (c >> 5), rr = r & 15, cc = c & 31, ob = rr * 64 + cc * 2; return st * 1024 + (ob ^ (((ob >> 9) & 1) << 5)); }
__host__ __device__ __forceinline__ void stage_rc(int b, int& R, int& C) { const int st = b / 1024, sb = b % 1024, swz = sb ^ (((sb >> 9) & 1) << 5); R = (st >> 1) * 16 + swz / 64; C = (st & 1) * 32 + (swz % 64) / 2; }
__host__ __device__ __forceinline__ int perm32(int rho) { const int n = rho >> 4, i = rho & 15; return 8 * (i >> 2) + 4 * n + (i & 3); }

struct Unit { int pm, pn; };
struct Gemm { const bf16_t* A; const bf16_t* Bt; int lda, ldb, K, a_pn_off, kshift, kbig, nM, nN; };

struct StaticOrder {
    int nM, nN, nwg, G, c;
    __device__ void init(int nM_, int nN_, int G_, int c_) { nM = nM_; nN = nN_; nwg = nM * nN; G = G_; c = c_; }
    __device__ bool next(int i, Unit& u) const {
        const long L = (long)i * G + c; if (L >= nwg) return false;
        int wgid = (int)L; { const int q = nwg / NXCD, r = nwg % NXCD, xcd = wgid % NXCD, off = wgid / NXCD; wgid = (xcd < r ? xcd * (q + 1) : r * (q + 1) + (xcd - r) * q) + off; }
        const int nig = WGM * nN, gid = wgid / nig, fm = gid * WGM, gsz = (nM - fm) < WGM ? (nM - fm) : WGM;
        u.pm = fm + ((wgid % nig) % gsz); u.pn = (wgid % nig) / gsz; return true;
    }
};

template <class Epi>
__device__ __forceinline__ void gemm_phase(LAS unsigned char* lds, const Gemm g, const int G, const int cidx, const Epi E) {
    const int tid = threadIdx.x, wid = __builtin_amdgcn_readfirstlane(tid >> 6), lane = tid & 63, wr = wid >> 2, wc = wid & 3, fr = lane & 15, fq = lane >> 4;
    const int K = g.K, nt = K / BK;
    StaticOrder S; S.init(g.nM, g.nN, G, cidx);
    unsigned voffA[2], voffB[2];
#pragma unroll
    for (int i = 0; i < 2; ++i) { int R, C; stage_rc(tid * 16 + i * 8192, R, C); const int Rb = (R & ~31) + perm32(R & 31);
        voffA[i] = (unsigned)(R * g.lda + C) * 2u; voffB[i] = (unsigned)(Rb * g.ldb + C) * 2u; }
    const size_t kstep = (size_t)(BK * 2);
    const size_t hstepA = (size_t)HALF * g.lda * 2, tstepA = 2 * hstepA;
    const size_t hstepB = (size_t)HALF * g.ldb * 2, tstepB = 2 * hstepB;
    const unsigned ldsw = (unsigned)wid * 1024u;
    const int aoff = lds_byte(wr * 64 + fr, fq * 8), boff = lds_byte(wc * 32 + fr, fq * 8);
#define PG8_KOA(t) (g.kshift >= 30 ? (size_t)(t) * 128 : (size_t)((t) >> g.kshift) * (size_t)g.kbig + (size_t)((t) & ((1 << g.kshift) - 1)) * 128)
#define PG8_SA(b, h) (((b) * 2 + (h)) * HTB)
#define PG8_SB(b, h) ((4 + (b) * 2 + (h)) * HTB)
#define PG8_STAGE(bufoff, gbase, voff) do { _Pragma("unroll") for (int _i = 0; _i < 2; ++_i) \
        __builtin_amdgcn_global_load_lds((const unsigned*)((const char*)(gbase) + (voff)[_i]), (LAS unsigned*)(lds + (bufoff) + ldsw + _i * 8192), 16, 0, 0); } while (0)
#define PG8_LDA(dst, b, h) do { _Pragma("unroll") for (int m = 0; m < 4; ++m) _Pragma("unroll") for (int k = 0; k < 2; ++k) dst[m][k] = *(const LAS bf16x8*)(lds + PG8_SA(b, h) + aoff + m * 2048 + k * 1024); } while (0)
#define PG8_LDB(dst, b, h) do { _Pragma("unroll") for (int n = 0; n < 2; ++n) _Pragma("unroll") for (int k = 0; k < 2; ++k) dst[n][k] = *(const LAS bf16x8*)(lds + PG8_SB(b, h) + boff + n * 2048 + k * 1024); } while (0)
#define PG8_MMA(ai, bj, At, Bt) do { __builtin_amdgcn_s_setprio(1); _Pragma("unroll") for (int m = 0; m < 4; ++m) _Pragma("unroll") for (int n = 0; n < 2; ++n) _Pragma("unroll") for (int k = 0; k < 2; ++k) \
        acc[ai][bj][m][n] = __builtin_amdgcn_mfma_f32_16x16x32_bf16(Bt[n][k], At[m][k], acc[ai][bj][m][n], 0, 0, 0); __builtin_amdgcn_s_setprio(0); } while (0)
#define PG8_WAIT_V(n) asm volatile("s_waitcnt vmcnt(" #n ")" ::: "memory")
#define PG8_WAIT_L(n) asm volatile("s_waitcnt lgkmcnt(" #n ")" ::: "memory")
#define PG8_BAR __builtin_amdgcn_s_barrier()
#define PG8_SCHED __builtin_amdgcn_sched_barrier(0)
    Unit cur, nxt; int ui = 0;
    if (!S.next(0, cur)) return;
    f32x4 acc[2][2][4][2];
#pragma unroll
    for (int a = 0; a < 2; ++a)
#pragma unroll
        for (int b = 0; b < 2; ++b)
#pragma unroll
            for (int m = 0; m < 4; ++m)
#pragma unroll
                for (int n = 0; n < 2; ++n) acc[a][b][m][n] = (f32x4){0.f, 0.f, 0.f, 0.f};
    bf16x8 At[4][2], B0[2][2], B1[2][2];
    const char* cA = (const char*)g.A + (size_t)cur.pm * tstepA + (size_t)cur.pn * (size_t)g.a_pn_off; const char* cB = (const char*)g.Bt + (size_t)cur.pn * tstepB;
    {
        PG8_STAGE(PG8_SB(0, 0), cB, voffB); PG8_STAGE(PG8_SB(0, 1), cB + hstepB, voffB); PG8_STAGE(PG8_SA(0, 0), cA, voffA); PG8_STAGE(PG8_SA(0, 1), cA + hstepA, voffA);
        if (wr == 1) PG8_BAR;
        PG8_WAIT_V(2); PG8_BAR;
        PG8_STAGE(PG8_SB(1, 0), cB + kstep, voffB); PG8_STAGE(PG8_SA(1, 0), cA + PG8_KOA(1), voffA); PG8_STAGE(PG8_SB(1, 1), cB + hstepB + kstep, voffB);
        PG8_WAIT_V(6); PG8_BAR;
    }
    for (;;) {
        const bool has_next = S.next(ui + 1, nxt);
        const char* nA = has_next ? (const char*)g.A + (size_t)nxt.pm * tstepA + (size_t)nxt.pn * (size_t)g.a_pn_off : cA; const char* nB = has_next ? (const char*)g.Bt + (size_t)nxt.pn * tstepB : cB;
#pragma clang loop unroll(disable)
        for (int t = 0; t < nt; t += 2) {
            const bool last = (t == nt - 2);
            const char* a1 = cA + PG8_KOA(t + 1);
            const char* a2 = last ? nA : cA + PG8_KOA(t + 2); const char* b2 = last ? nB : cB + (size_t)(t + 2) * kstep;
            const char* a3 = last ? nA + PG8_KOA(1) : cA + PG8_KOA(t + 3); const char* b3 = b2 + kstep;
            PG8_LDB(B0, 0, 0); PG8_LDB(B1, 0, 1); PG8_SCHED; PG8_LDA(At, 0, 0); PG8_STAGE(PG8_SA(1, 1), a1 + hstepA, voffA);
            PG8_WAIT_V(8); PG8_WAIT_L(0); PG8_BAR; PG8_MMA(0, 0, At, B0); PG8_MMA(0, 1, At, B1); PG8_BAR; PG8_SCHED;
            PG8_LDA(At, 0, 1); PG8_STAGE(PG8_SB(0, 0), b2, voffB); PG8_STAGE(PG8_SB(0, 1), b2 + hstepB, voffB); PG8_STAGE(PG8_SA(0, 0), a2, voffA);
            PG8_WAIT_V(8); PG8_WAIT_L(0); PG8_BAR; PG8_MMA(1, 0, At, B0); PG8_MMA(1, 1, At, B1); PG8_BAR; PG8_SCHED;
            PG8_LDB(B0, 1, 0); PG8_LDB(B1, 1, 1); PG8_SCHED; PG8_LDA(At, 1, 0); PG8_STAGE(PG8_SA(0, 1), a2 + hstepA, voffA);
            PG8_WAIT_V(8); PG8_WAIT_L(0); PG8_BAR; PG8_MMA(0, 0, At, B0); PG8_MMA(0, 1, At, B1); PG8_BAR; PG8_SCHED;
            PG8_LDA(At, 1, 1); PG8_STAGE(PG8_SB(1, 0), b3, voffB); PG8_STAGE(PG8_SB(1, 1), b3 + hstepB, voffB); PG8_STAGE(PG8_SA(1, 0), a3, voffA);
            PG8_WAIT_V(8); PG8_WAIT_L(0); PG8_BAR; PG8_MMA(1, 0, At, B0); PG8_MMA(1, 1, At, B1); PG8_BAR; PG8_SCHED;
        }
        if (wr == 0) PG8_BAR;
        E(acc, cur, wr, wc, fr, fq);
        if (!has_next) break;
#pragma unroll
        for (int a = 0; a < 2; ++a)
#pragma unroll
            for (int b = 0; b < 2; ++b)
#pragma unroll
                for (int m = 0; m < 4; ++m)
#pragma unroll
                    for (int n = 0; n < 2; ++n) acc[a][b][m][n] = (f32x4){0.f, 0.f, 0.f, 0.f};
        cur = nxt; cA = nA; cB = nB; ++ui;
        if (wr == 1) PG8_BAR;
    }
    PG8_WAIT_V(0);
    PG8_BAR;
#undef PG8_KOA
#undef PG8_SA
#undef PG8_SB
#undef PG8_STAGE
#undef PG8_LDA
#undef PG8_LDB
#undef PG8_MMA
#undef PG8_WAIT_V
#undef PG8_WAIT_L
#undef PG8_BAR
#undef PG8_SCHED
}

typedef const f32x4 (&AccRef)[2][2][4][2];
#define EPI_ROWS const int row0 = u.pm * BM + wr * 64 + fr
#define EPI_FOR_AM _Pragma("unroll") for (int ai = 0; ai < 2; ++ai) _Pragma("unroll") for (int m = 0; m < 4; ++m)
#define EPI_ROWSCALE(arr, ptr) float arr[2][4]; EPI_FOR_AM arr[ai][m] = (ptr)[row0 + ai * HALF + m * 16]

struct EpiPlain {
    bf16_t* O; int ldc;
    __device__ __forceinline__ void operator()(AccRef acc, const Unit& u, int wr, int wc, int fr, int fq) const {
        EPI_ROWS; const int col0 = u.pn * BM + wc * 32 + 8 * fq;
        EPI_FOR_AM { bf16_t* rp = O + (size_t)(row0 + ai * HALF + m * 16) * ldc + col0;
#pragma unroll
            for (int bj = 0; bj < 2; ++bj) *(u32x4*)(rp + bj * HALF) = pack8(acc[ai][bj][m][0], acc[ai][bj][m][1]); }
    }
};
struct EpiSwiGLU {
    bf16_t* O; const float* rstd;
    __device__ __forceinline__ void operator()(AccRef acc, const Unit& u, int wr, int wc, int fr, int fq) const {
        EPI_ROWS; const int col0 = u.pn * HALF + wc * 32 + 8 * fq;
        EPI_ROWSCALE(rsv, rstd);
        EPI_FOR_AM { f32x4 a, b; const float rs = rsv[ai][m];
#pragma unroll
            for (int j = 0; j < 4; ++j) { a[j] = fsilu(acc[ai][0][m][0][j] * rs) * (acc[ai][1][m][0][j] * rs); b[j] = fsilu(acc[ai][0][m][1][j] * rs) * (acc[ai][1][m][1][j] * rs); }
            *(u32x4*)(O + (size_t)(row0 + ai * HALF + m * 16) * DFF + col0) = pack8(a, b); }
    }
};
struct EpiSsq {
    bf16_t* O; float* ssq;
    __device__ __forceinline__ void operator()(AccRef acc, const Unit& u, int wr, int wc, int fr, int fq) const {
        EPI_ROWS; const int col0 = u.pn * BM + wc * 32 + 8 * fq;
        EPI_FOR_AM { const int row = row0 + ai * HALF + m * 16; bf16_t* rp = O + (size_t)row * DM + col0; float s = 0.f;
#pragma unroll
            for (int bj = 0; bj < 2; ++bj) { const f32x4 v0 = acc[ai][bj][m][0], v1 = acc[ai][bj][m][1];
                s += (v0[0] * v0[0] + v0[1] * v0[1]) + (v0[2] * v0[2] + v0[3] * v0[3]) + (v1[0] * v1[0] + v1[1] * v1[1]) + (v1[2] * v1[2] + v1[3] * v1[3]);
                *(u32x4*)(rp + bj * HALF) = pack8(v0, v1); }
            s = xsum_rows(s);
            if (fq == 0) ssq[(size_t)row * 32 + u.pn * 4 + wc] = s; }
    }
};
struct EpiWin {
    bf16_t* Zlo; bf16_t* Cqkv; bf16_t* Zg; float* ssqc; const float* rstd;
    template <int MODE  >
    __device__ __forceinline__ void body(AccRef acc, const Unit& u, int wr, int wc, int fr, int fq, bf16_t* base, const int ldc, const int pnl) const {
        EPI_ROWS; const int col0 = pnl * BM + wc * 32 + 8 * fq;
        EPI_ROWSCALE(rsv, rstd);
        EPI_FOR_AM { const int row = row0 + ai * HALF + m * 16; const float rs = rsv[ai][m]; bf16_t* rp = base + (size_t)row * ldc + col0; float sq = 0.f;
#pragma unroll
            for (int bj = 0; bj < 2; ++bj) { f32x4 v0 = acc[ai][bj][m][0] * rs, v1 = acc[ai][bj][m][1] * rs;
                if (MODE == 2) {
#pragma unroll
                    for (int j = 0; j < 4; ++j) { v0[j] = fsigmoid(v0[j]); v1[j] = fsigmoid(v1[j]); } }
                if (MODE == 1) sq += (v0[0] * v0[0] + v0[1] * v0[1]) + (v0[2] * v0[2] + v0[3] * v0[3]) + (v1[0] * v1[0] + v1[1] * v1[1]) + (v1[2] * v1[2] + v1[3] * v1[3]);
                *(u32x4*)(rp + bj * HALF) = pack8(v0, v1); }
            if (MODE == 1) { sq = xsum_rows(sq); if (fq == 0) ssqc[(size_t)row * 16 + pnl * 4 + wc] = sq; } }
    }
    __device__ __forceinline__ void operator()(AccRef acc, const Unit& u, int wr, int wc, int fr, int fq) const {
        if (u.pn >= 8) body<2>(acc, u, wr, wc, fr, fq, Zg, 4096, u.pn - 8);
        else if (u.pn >= 4) body<1>(acc, u, wr, wc, fr, fq, Cqkv, 1024, u.pn - 4);
        else body<0>(acc, u, wr, wc, fr, fq, Zlo, 2048, u.pn);
    }
};
struct EpiQ {
    bf16_t* Q; const float* cs; const float* sn; const float* rq;
    __device__ __forceinline__ void operator()(AccRef acc, const Unit& u, int wr, int wc, int fr, int fq) const {
        EPI_ROWS;
        EPI_ROWSCALE(rqv, rq);
        if (u.pn < 8) {
            EPI_FOR_AM { const float qs = QSCALE * rqv[ai][m]; bf16_t* rp = Q + (size_t)(row0 + ai * HALF + m * 16) * QW + wc * 32 + 8 * fq;
#pragma unroll
                for (int bj = 0; bj < 2; ++bj) *(u32x4*)(rp + (2 * u.pn + bj) * 192) = pack8(acc[ai][bj][m][0] * qs, acc[ai][bj][m][1] * qs); }
        } else {
            const int head = 4 * (u.pn - 8) + wc;
#pragma unroll
            for (int am = 0; am < 4; ++am) { const int ai = am >> 1;
                f32x4 cv[2][2], sv[2][2];
#pragma unroll
                for (int mm = 0; mm < 2; ++mm) { const int pos = NMETA + ((row0 + ai * HALF + (2 * (am & 1) + mm) * 16) & (SEQ - 1));
                    cv[mm][0] = *(const f32x4*)(cs + pos * 32 + 8 * fq); cv[mm][1] = *(const f32x4*)(cs + pos * 32 + 8 * fq + 4);
                    sv[mm][0] = *(const f32x4*)(sn + pos * 32 + 8 * fq); sv[mm][1] = *(const f32x4*)(sn + pos * 32 + 8 * fq + 4); }
#pragma unroll
                for (int mm = 0; mm < 2; ++mm) { const int m = 2 * (am & 1) + mm; const int row = row0 + ai * HALF + m * 16; const float qs = QSCALE * rqv[ai][m];
                const f32x4 c0 = cv[mm][0], c1 = cv[mm][1], s0 = sv[mm][0], s1 = sv[mm][1];
                const f32x4 x10 = acc[ai][0][m][0], x11 = acc[ai][0][m][1], x20 = acc[ai][1][m][0], x21 = acc[ai][1][m][1];
                const f32x4 o10 = (x10 * c0 - x20 * s0) * qs, o11 = (x11 * c1 - x21 * s1) * qs;
                const f32x4 o20 = (x20 * c0 + x10 * s0) * qs, o21 = (x21 * c1 + x11 * s1) * qs;
                bf16_t* rp = Q + (size_t)row * QW + head * 192 + 128 + 8 * fq;
                *(u32x4*)(rp) = pack8(o10, o11); *(u32x4*)(rp + 32) = pack8(o20, o21); } }
        }
    }
};
struct EpiKn {
    bf16_t* Kn; const float* rk;
    __device__ __forceinline__ void operator()(AccRef acc, const Unit& u, int wr, int wc, int fr, int fq) const {
        EPI_ROWS; const int col0 = u.pn * BM + wc * 32 + 8 * fq;
        EPI_ROWSCALE(rkv, rk);
        EPI_FOR_AM { const int row = row0 + ai * HALF + m * 16; const size_t kr = (size_t)(row >> 12) * LP + NMETA + (row & (SEQ - 1)); bf16_t* rp = Kn + kr * DM + col0;
#pragma unroll
            for (int bj = 0; bj < 2; ++bj) *(u32x4*)(rp + bj * HALF) = pack8(acc[ai][bj][m][0] * rkv[ai][m], acc[ai][bj][m][1] * rkv[ai][m]); }
    }
};
struct EpiVt {
    bf16_t* Vt; const float* rk;
    __device__ __forceinline__ void operator()(AccRef acc, const Unit& u, int wr, int wc, int fr, int fq) const {
        EPI_ROWS; const int col0 = u.pn * BM + wc * 32 + 8 * fq;
        f32x4 rv[2][2];
#pragma unroll
        for (int bj = 0; bj < 2; ++bj) { rv[bj][0] = *(const f32x4*)(rk + col0 + bj * HALF); rv[bj][1] = *(const f32x4*)(rk + col0 + bj * HALF + 4); }
        EPI_FOR_AM { const int rp_ = row0 + ai * HALF + m * 16;
#pragma unroll
            for (int bj = 0; bj < 2; ++bj) { const int c = col0 + bj * HALF; const int b = c >> 12, s = c & (SEQ - 1);
                *(u32x4*)(Vt + vt_idx(b, rp_, NMETA + s)) = pack8(acc[ai][bj][m][0] * rv[bj][0], acc[ai][bj][m][1] * rv[bj][1]); } }
    }
};
struct EpiGate1 {
    bf16_t* T; const bf16_t* Zg;
    __device__ __forceinline__ void operator()(AccRef acc, const Unit& u, int wr, int wc, int fr, int fq) const {
        EPI_ROWS; const int col0 = u.pn * BM + wc * 32 + 8 * fq;
#pragma unroll
        for (int ai = 0; ai < 2; ++ai) {
            u32x4 gv[4][2];
#pragma unroll
            for (int m = 0; m < 4; ++m)
#pragma unroll
                for (int bj = 0; bj < 2; ++bj) gv[m][bj] = *(const u32x4*)(Zg + (size_t)(row0 + ai * HALF + m * 16) * 4096 + col0 + bj * HALF);
#pragma unroll
            for (int m = 0; m < 4; ++m) { const int row = row0 + ai * HALF + m * 16;
#pragma unroll
                for (int bj = 0; bj < 2; ++bj) { float gf[8]; unpack8(gv[m][bj], gf);
                    f32x4 v0 = acc[ai][bj][m][0], v1 = acc[ai][bj][m][1];
#pragma unroll
                    for (int j = 0; j < 4; ++j) { v0[j] *= gf[j]; v1[j] *= gf[4 + j]; }
                    *(u32x4*)(T + (size_t)row * DM + col0 + bj * HALF) = pack8(v0, v1); } } }
    }
};
struct EpiGate2 {
    bf16_t* Y; const bf16_t* T; const bf16_t* Zg;
    __device__ __forceinline__ void operator()(AccRef acc, const Unit& u, int wr, int wc, int fr, int fq) const {
        EPI_ROWS; const int col0 = u.pn * BM + wc * 32 + 8 * fq;
#pragma unroll
        for (int ai = 0; ai < 2; ++ai) {
            u32x4 gv[4][2], tv[4][2];
#pragma unroll
            for (int m = 0; m < 4; ++m)
#pragma unroll
                for (int bj = 0; bj < 2; ++bj) { const int row = row0 + ai * HALF + m * 16;
                    gv[m][bj] = *(const u32x4*)(Zg + (size_t)row * 4096 + 2048 + col0 + bj * HALF); tv[m][bj] = *(const u32x4*)(T + (size_t)row * DM + col0 + bj * HALF); }
#pragma unroll
            for (int m = 0; m < 4; ++m) { const int row = row0 + ai * HALF + m * 16;
#pragma unroll
                for (int bj = 0; bj < 2; ++bj) { float gf[8]; unpack8(gv[m][bj], gf); float tf[8]; unpack8(tv[m][bj], tf);
                    f32x4 v0 = acc[ai][bj][m][0], v1 = acc[ai][bj][m][1];
#pragma unroll
                    for (int j = 0; j < 4; ++j) { v0[j] = tf[j] + v0[j] * gf[j]; v1[j] = tf[4 + j] + v1[j] * gf[4 + j]; }
                    *(u32x4*)(Y + (size_t)row * DM + col0 + bj * HALF) = pack8(v0, v1); } } }
    }
};
}

template <int RB, int CB>
__device__ __forceinline__ void skinny(const bf16_t* A, int lda, const bf16_t* W, int ldw, int cbrows, int K, f32x4 (&acc)[RB][CB], int lane) {
    const int fr = lane & 15, fq = lane >> 4;
    const bf16_t* ap = A + (size_t)fr * lda + fq * 32;
    const bf16_t* wp = W + (size_t)fr * ldw + fq * 32;
#pragma unroll
    for (int rb = 0; rb < RB; ++rb)
#pragma unroll
        for (int cb = 0; cb < CB; ++cb) acc[rb][cb] = (f32x4){0.f, 0.f, 0.f, 0.f};
#pragma clang loop unroll_count((RB * CB == 1) ? 4 : 2)
    for (int k0 = 0; k0 < K; k0 += 128) {
        bf16x8 av[RB][4], wv[CB][4];
#pragma unroll
        for (int rb = 0; rb < RB; ++rb)
#pragma unroll
            for (int e = 0; e < 4; ++e) av[rb][e] = *(const bf16x8*)(ap + (size_t)rb * 16 * lda + k0 + e * 8);
#pragma unroll
        for (int cb = 0; cb < CB; ++cb)
#pragma unroll
            for (int e = 0; e < 4; ++e) wv[cb][e] = *(const bf16x8*)(wp + (size_t)cb * cbrows * ldw + k0 + e * 8);
#pragma unroll
        for (int e = 0; e < 4; ++e)
#pragma unroll
            for (int rb = 0; rb < RB; ++rb)
#pragma unroll
                for (int cb = 0; cb < CB; ++cb) acc[rb][cb] = __builtin_amdgcn_mfma_f32_16x16x32_bf16(wv[cb][e], av[rb][e], acc[rb][cb], 0, 0, 0);
    }
}

__device__ __forceinline__ void transpose_item(const float* W, int ldw, int K, bf16_t* WT, int drow0, int scol0, int k0, LAS float* scr, int lane, const float* kg) {
    float tv[32];
    const float* wsrc = W + (size_t)(k0 + (lane >> 5)) * ldw + scol0 + (lane & 31);
#pragma unroll
    for (int i = 0; i < 32; ++i) tv[i] = wsrc[(size_t)(2 * i) * ldw];
    if (kg) {
#pragma unroll
        for (int i = 0; i < 32; ++i) tv[i] *= kg[k0 + 2 * i + (lane >> 5)]; }
#pragma unroll
    for (int i = 0; i < 32; ++i) scr[(2 * i + (lane >> 5)) * 33 + (lane & 31)] = tv[i];
    asm volatile("s_waitcnt lgkmcnt(0)" ::: "memory");
    const int c = lane & 7;
#pragma unroll
    for (int j = 0; j < 4; ++j) { const int n = (lane >> 3) + 8 * j; const LAS float* s = scr + (8 * c) * 33 + n;
        u32x4 o; o.x = pk2(s[0 * 33], s[1 * 33]); o.y = pk2(s[2 * 33], s[3 * 33]); o.z = pk2(s[4 * 33], s[5 * 33]); o.w = pk2(s[6 * 33], s[7 * 33]);
        *(u32x4*)(WT + (size_t)(drow0 + n) * K + k0 + 8 * c) = o; }
    asm volatile("s_waitcnt lgkmcnt(0)" ::: "memory");
}
__device__ __forceinline__ int srccol(int id, int r0) {
    switch (id) {
    case 0: { const int tile = r0 >> 8, r = r0 & 255; return (r < 128) ? 128 * tile + r : DFF + 128 * tile + (r - 128); }
    case 2: return r0 < 2048 ? r0 : r0 + 64;
    case 3: return 2048 + r0;
    case 4: { const int pn = r0 >> 8, r = r0 & 255, bj = r >> 7, rr = r & 127;
              return pn < 8 ? (2 * pn + bj) * 192 + rr : (4 * (pn - 8) + (rr >> 5)) * 192 + 128 + 32 * bj + (rr & 31); }
    case 5: return (r0 >> 7) * 256 + (r0 & 127);
    case 6: return (r0 >> 7) * 256 + 128 + (r0 & 127);
    default: return r0;
    }
}
__device__ __forceinline__ void conv_matrix(const float* W, int ldw, int K, int nrows, int id, bf16_t* WT, LAS float* scr, int lane, int& it, const int NGW, const float* kg = nullptr) {
    const int nblk = nrows / 32, nitems = (K / 64) * nblk;
    for (; it < nitems; it += NGW) { const int kb = it / nblk, nb = it % nblk; transpose_item(W, ldw, K, WT, 32 * nb, srccol(id, 32 * nb), 64 * kb, scr, lane, kg); }
    it -= nitems;
}

__device__ __forceinline__ void ld_row_f32(const float* p, int lane, f32x4 (&v)[8]) {
#pragma unroll
    for (int j = 0; j < 8; ++j) v[j] = *(const f32x4*)(p + 4 * lane + 256 * j);
}
__device__ __forceinline__ void ld_row_bf16(const bf16_t* p, int lane, f32x4 (&v)[8]) {
#pragma unroll
    for (int j = 0; j < 8; ++j) { const u32x2 w = *(const u32x2*)(p + 4 * lane + 256 * j); v[j] = (f32x4){bflo(w.x), bfhi(w.x), bflo(w.y), bfhi(w.y)}; }
}
__device__ __forceinline__ float row_ssq(const f32x4 (&v)[8]) {
    float s = 0.f;
#pragma unroll
    for (int j = 0; j < 8; ++j) s += (v[j][0] * v[j][0] + v[j][1] * v[j][1]) + (v[j][2] * v[j][2] + v[j][3] * v[j][3]);
    return wave_sum(s);
}
__device__ __forceinline__ void st_row_norm_bf16(bf16_t* dst, const f32x4 (&v)[8], float rstd, const float* gain, int lane) {
#pragma unroll
    for (int j = 0; j < 8; ++j) { const f32x4 g = *(const f32x4*)(gain + 4 * lane + 256 * j); const f32x4 o = v[j] * rstd * g;
        u32x2 w; w.x = pk2(o[0], o[1]); w.y = pk2(o[2], o[3]); *(u32x2*)(dst + 4 * lane + 256 * j) = w; }
}
__device__ __forceinline__ void st_row_bf16(bf16_t* dst, const f32x4 (&v)[8], int lane) {
#pragma unroll
    for (int j = 0; j < 8; ++j) { u32x2 w; w.x = pk2(v[j][0], v[j][1]); w.y = pk2(v[j][2], v[j][3]); *(u32x2*)(dst + 4 * lane + 256 * j) = w; }
}
__device__ __forceinline__ void st_row_scaled_bf16(bf16_t* dst, const f32x4 (&v)[8], float rstd, int lane) {
#pragma unroll
    for (int j = 0; j < 8; ++j) { const f32x4 o = v[j] * rstd; u32x2 w; w.x = pk2(o[0], o[1]); w.y = pk2(o[2], o[3]); *(u32x2*)(dst + 4 * lane + 256 * j) = w; }
}
__device__ __forceinline__ void add_normed_g(f32x4 (&v)[8], const f32x4 (&d)[8], float scale_rstd, const f32x4 (&g)[8]) {
#pragma unroll
    for (int j = 0; j < 8; ++j) v[j] += d[j] * scale_rstd * g[j];
}
__device__ __forceinline__ void add_normed(f32x4 (&v)[8], const f32x4 (&d)[8], float scale_rstd, const float* gain, int lane) {
#pragma unroll
    for (int j = 0; j < 8; ++j) { const f32x4 g = *(const f32x4*)(gain + 4 * lane + 256 * j); v[j] += d[j] * scale_rstd * g; }
}

constexpr int AT_KROW = 400, AT_KBUF = 64 * AT_KROW, AT_VROW = 144, AT_VBUF = 128 * AT_VROW, AT_NST = 3, AT_VOFF = AT_NST * AT_KBUF;
__device__ __forceinline__ int crow(int r, int hi) { return (r & 3) + 8 * (r >> 2) + 4 * hi; }
__device__ __forceinline__ void attn_unit(const int b, const int h, const int qb, const bf16_t* Q, bf16_t* Od, const int ldo, const int hso, const bf16_t* __restrict__ Kn, const bf16_t* __restrict__ Kpe, const bf16_t* __restrict__ Vt, LAS unsigned char* lds) {
    const int tid = threadIdx.x, lane = tid & 63, r32 = lane & 31, hi = lane >> 5; const int wid = __builtin_amdgcn_readfirstlane(tid >> 6);
    const int qrow = b * SEQ + qb * 256 + wid * 32 + r32;
    const int qpos0 = NMETA + qb * 256 + wid * 32, qpos = qpos0 + r32;
    bf16x8 qf[12];
#pragma unroll
    for (int d0 = 0; d0 < 12; ++d0) qf[d0] = *(const bf16x8*)(Q + (size_t)qrow * QW + h * 192 + d0 * 16 + hi * 8);
    f32x16 o[4];
#pragma unroll
    for (int i = 0; i < 4; ++i)
#pragma unroll
        for (int r = 0; r < 16; ++r) o[i][r] = 0.f;
    float mrun = -1e30f, lrun = 0.f;
    const int NT = 4 * qb + 5;
    const int kr0 = tid >> 4, kc0 = tid & 15;
    const int pr = tid >> 3, pc = tid & 7;
    const int vr0 = tid >> 3, vc0 = tid & 7;
    const int vso = (vc0 >> 1) * 32 + (vc0 & 1) * 8;
    const unsigned kno = (unsigned)((b * LP + kr0) * DM + h * 128 + kc0 * 8);
    const unsigned kpo = (unsigned)((b * LP + pr) * 64 + pc * 8);
    const unsigned vto = (unsigned)((((b * NH + h) * 65) * 128 + vr0) * 64 + vc0 * 8);
    u32x4 kreg[2], preg, vreg[2];
    f32x16 s0, s1;
#define AT_LOAD(t) do { kreg[0] = *(const u32x4*)(Kn + (kno + (unsigned)(64 * (t)) * DM)); kreg[1] = *(const u32x4*)(Kn + (kno + (unsigned)(64 * (t) + 32) * DM)); \
        preg = *(const u32x4*)(Kpe + (kpo + (unsigned)(64 * (t)) * 64)); vreg[0] = *(const u32x4*)(Vt + (vto + (unsigned)(8192 * (t)))); vreg[1] = *(const u32x4*)(Vt + (vto + (unsigned)(4096 + 8192 * (t)))); } while (0)
#define AT_STORE(stg) do { LAS unsigned char* kb_ = lds + (stg) * AT_KBUF; LAS unsigned char* vb_ = lds + AT_VOFF + (stg) * AT_VBUF; \
        *(LAS u32x4*)(kb_ + kr0 * AT_KROW + kc0 * 16) = kreg[0]; *(LAS u32x4*)(kb_ + (kr0 + 32) * AT_KROW + kc0 * 16) = kreg[1]; \
        *(LAS u32x4*)(kb_ + pr * AT_KROW + 256 + pc * 16) = preg; \
        *(LAS u32x2*)(vb_ + vr0 * AT_VROW + vso) = (u32x2){vreg[0].x, vreg[0].y}; *(LAS u32x2*)(vb_ + vr0 * AT_VROW + vso + 16) = (u32x2){vreg[0].z, vreg[0].w}; \
        *(LAS u32x2*)(vb_ + (vr0 + 64) * AT_VROW + vso) = (u32x2){vreg[1].x, vreg[1].y}; *(LAS u32x2*)(vb_ + (vr0 + 64) * AT_VROW + vso + 16) = (u32x2){vreg[1].z, vreg[1].w}; } while (0)
#define AT_QK(stg, tt) do { \
        _Pragma("unroll") for (int r = 0; r < 16; ++r) { s0[r] = 0.f; s1[r] = 0.f; } \
        const LAS unsigned char* kb = lds + (stg) * AT_KBUF + r32 * AT_KROW + hi * 16; \
        _Pragma("unroll") for (int d0 = 0; d0 < 12; ++d0) { \
            const bf16x8 a0 = *(const LAS bf16x8*)(kb + d0 * 32), a1 = *(const LAS bf16x8*)(kb + 32 * AT_KROW + d0 * 32); \
            s0 = __builtin_amdgcn_mfma_f32_32x32x16_bf16(a0, qf[d0], s0, 0, 0, 0); \
            s1 = __builtin_amdgcn_mfma_f32_32x32x16_bf16(a1, qf[d0], s1, 0, 0, 0); \
            } \
        if (64 * (tt) + 63 > qpos0) { \
            _Pragma("unroll") for (int r = 0; r < 16; ++r) { const int kv = 64 * (tt) + crow(r, hi); if (kv > qpos) s0[r] = -1e30f; if (kv + 32 > qpos) s1[r] = -1e30f; } } \
    } while (0)
#define AT_SPV(stg) do { \
        float mx = fmaxf(s0[0], s1[0]); \
        _Pragma("unroll") for (int r = 1; r < 16; ++r) mx = fmaxf(mx, fmaxf(s0[r], s1[r])); \
        { auto rr_ = __builtin_amdgcn_permlane32_swap(__float_as_uint(mx), __float_as_uint(mx), false, false); mx = fmaxf(__uint_as_float(rr_[0]), __uint_as_float(rr_[1])); } \
        const float mnew = fmaxf(mrun, mx), alpha = __builtin_amdgcn_exp2f(mrun - mnew); mrun = mnew; \
        float rs = 0.f; \
        _Pragma("unroll") for (int r = 0; r < 16; ++r) { s0[r] = __builtin_amdgcn_exp2f(s0[r] - mnew); s1[r] = __builtin_amdgcn_exp2f(s1[r] - mnew); rs += s0[r] + s1[r]; } \
        lrun = lrun * alpha + rs; \
        if (__builtin_amdgcn_ballot_w64(alpha != 1.0f) != 0ull) { \
            _Pragma("unroll") for (int i = 0; i < 4; ++i) _Pragma("unroll") for (int r = 0; r < 16; ++r) o[i][r] *= alpha; } \
        bf16x8 pf[4]; \
        { u32x4 w; \
          w.x = pk2(s0[0], s0[1]); w.y = pk2(s0[2], s0[3]); w.z = pk2(s0[4], s0[5]); w.w = pk2(s0[6], s0[7]); pf[0] = __builtin_bit_cast(bf16x8, w); \
          w.x = pk2(s0[8], s0[9]); w.y = pk2(s0[10], s0[11]); w.z = pk2(s0[12], s0[13]); w.w = pk2(s0[14], s0[15]); pf[1] = __builtin_bit_cast(bf16x8, w); \
          w.x = pk2(s1[0], s1[1]); w.y = pk2(s1[2], s1[3]); w.z = pk2(s1[4], s1[5]); w.w = pk2(s1[6], s1[7]); pf[2] = __builtin_bit_cast(bf16x8, w); \
          w.x = pk2(s1[8], s1[9]); w.y = pk2(s1[10], s1[11]); w.z = pk2(s1[12], s1[13]); w.w = pk2(s1[14], s1[15]); pf[3] = __builtin_bit_cast(bf16x8, w); } \
        const LAS unsigned char* vb = lds + AT_VOFF + (stg) * AT_VBUF + r32 * AT_VROW + hi * 16; \
        _Pragma("unroll") for (int db = 0; db < 4; ++db) _Pragma("unroll") for (int kb4 = 0; kb4 < 4; ++kb4) { \
            const u32x4 vv = *(const LAS u32x4*)(vb + db * 32 * AT_VROW + kb4 * 32); \
            o[db] = __builtin_amdgcn_mfma_f32_32x32x16_bf16(__builtin_bit_cast(bf16x8, vv), pf[kb4], o[db], 0, 0, 0); \
            } \
    } while (0)
    if (wid >= 4) __builtin_amdgcn_s_setprio(1);
    AT_LOAD(0);
#pragma unroll
    for (int d0 = 0; d0 < 12; ++d0) asm volatile("" : "+v"(qf[d0]));
    AT_STORE(0);
    __syncthreads();
    int st_prev = 2, st_cur = 0, st_next = 1;
    const int tlast = (qpos0 + 31) >> 6;
#define AT_ROT() do { st_prev = st_cur; st_cur = st_next; st_next = (st_next == AT_NST - 1) ? 0 : st_next + 1; } while (0)
#ifndef AT_PINGPONG
#define AT_PINGPONG 0
#endif
    if (!AT_PINGPONG || wid < 4) {
#pragma clang loop unroll(disable)
        for (int t = 0; t < NT + AT_PINGPONG; ++t) {
            if (t + 1 < NT) AT_LOAD(t + 1);
            if (t <= tlast) { AT_QK(st_cur, t); AT_SPV(st_cur); }
            if (t + 1 < NT) AT_STORE(st_next);
            __syncthreads();
            AT_ROT();
        }
    } else {
#pragma clang loop unroll(disable)
        for (int t = 0; t <= NT; ++t) {
            if (t >= 1 && t - 1 <= tlast) AT_SPV(st_prev);
            asm volatile("" ::: "memory");
            if (t + 1 < NT) AT_LOAD(t + 1);
            if (t <= tlast) AT_QK(st_cur, t);
            if (t + 1 < NT) AT_STORE(st_next);
            __syncthreads();
            AT_ROT();
        }
    }
#undef AT_ROT
#undef AT_LOAD
#undef AT_STORE
#undef AT_QK
#undef AT_SPV
    __builtin_amdgcn_s_setprio(0);
    const float l = lrun + __shfl_xor(lrun, 32), inv = 1.f / l;
    bf16_t* op = Od + (size_t)qrow * ldo + h * hso;
#pragma unroll
    for (int db = 0; db < 4; ++db)
#pragma unroll
        for (int k = 0; k < 2; ++k) { const int ga = 8 * k, gb = 8 * k + 4;
            const unsigned ax = pk2(o[db][ga] * inv, o[db][ga + 1] * inv), ay = pk2(o[db][ga + 2] * inv, o[db][ga + 3] * inv);
            const unsigned bx_ = pk2(o[db][gb] * inv, o[db][gb + 1] * inv), by_ = pk2(o[db][gb + 2] * inv, o[db][gb + 3] * inv);
            const auto rx = __builtin_amdgcn_permlane32_swap(ax, bx_, false, false); const auto ry = __builtin_amdgcn_permlane32_swap(ay, by_, false, false);
            const u32x4 v = {rx[0], ry[0], rx[1], ry[1]};
            *(u32x4*)(op + 32 * db + 16 * k + 8 * hi) = v; }
}

#define XB_TMO      128
#define XB_XCNT(j)  (256  + 64 * (j))
#define XB_XSUB(j)  (1280 + 64 * (j))
#define XB_XGEN(j)  (2304 + 64 * (j))
#define XB_TOP      3328
#define XB_TOPGEN   3392
#define XCD_BAR_WORDS 3456
#define XB_SPIN_CAP (1u << 22)
__device__ __forceinline__ unsigned xb_ld(unsigned* p)              { return __hip_atomic_load(p, __ATOMIC_RELAXED, __HIP_MEMORY_SCOPE_AGENT); }
__device__ __forceinline__ unsigned xb_add(unsigned* p, unsigned v) { return __hip_atomic_fetch_add(p, v, __ATOMIC_RELAXED, __HIP_MEMORY_SCOPE_AGENT); }
__device__ __forceinline__ unsigned xb_xcc_id() { return (unsigned)__builtin_amdgcn_s_getreg((3 << 11) | 20) & 0xFu; }
#define XB_SPIN(cond, bar) do { unsigned _sp = 0; while (cond) { __builtin_amdgcn_s_sleep(1); \
    if ((++_sp & 255u) == 0u) { if (xb_ld(&(bar)[XB_TMO])) break; if (_sp > XB_SPIN_CAP) { atomicAdd(&(bar)[XB_TMO], 1u); break; } } } } while (0)
struct XcdBarrier { unsigned* bar; unsigned x; volatile LAS unsigned* st; };
__device__ __forceinline__ XcdBarrier xcd_barrier_post(unsigned* bar, volatile LAS unsigned* st) {
    XcdBarrier b; b.bar = bar; b.x = xb_xcc_id(); b.st = st;
    if (threadIdx.x == 0) (void)xb_add(&bar[XB_XCNT(b.x)], 1u);
    return b;
}
__device__ __forceinline__ void xcd_barrier_complete(unsigned* bar, unsigned x, unsigned& nloc, unsigned& nx) {
    const unsigned G = gridDim.x * gridDim.y * gridDim.z;
    unsigned sum, cnt, mine, sp = 0u;
    for (;;) {
        sum = 0u; cnt = 0u; mine = 0u;
#pragma unroll
        for (unsigned j = 0; j < 16; ++j) { const unsigned c = xb_ld(&bar[XB_XCNT(j)]); sum += c; cnt += (c > 0u) ? 1u : 0u; mine = (j == x) ? c : mine; }
        if (sum == G) break;
        __builtin_amdgcn_s_sleep(1);
        if ((++sp & 255u) == 0u) { if (xb_ld(&bar[XB_TMO])) break; if (sp > XB_SPIN_CAP) { atomicAdd(&bar[XB_TMO], 1u); break; } }
    }
    nloc = mine > 0u ? mine : 1u; nx = cnt > 0u ? cnt : 1u;
}
__device__ __forceinline__ void xcd_barrier(const XcdBarrier& b) {
    asm volatile("s_waitcnt vmcnt(0)" ::: "memory");
    __syncthreads();
    if (threadIdx.x == 0) {
        unsigned* bar = b.bar;
        __builtin_amdgcn_s_waitcnt(0);
        unsigned nloc = b.st[0], nx = b.st[1];
        if (nloc == 0u) { xcd_barrier_complete(bar, b.x, nloc, nx); b.st[0] = nloc; b.st[1] = nx; }
        const unsigned old = xb_add(&bar[XB_XSUB(b.x)], 1u);
        const unsigned gen = old / nloc;
        if (old + 1u == (gen + 1u) * nloc) {
            __builtin_amdgcn_fence(__ATOMIC_RELEASE, "agent");
            asm volatile("s_waitcnt vmcnt(0)" ::: "memory");
            const unsigned og = xb_add(&bar[XB_TOP], 1u);
            const unsigned tg = og / nx;
            if (og + 1u == (tg + 1u) * nx) xb_add(&bar[XB_TOPGEN], 1u);
            else XB_SPIN(xb_ld(&bar[XB_TOPGEN]) == tg, bar);
            __builtin_amdgcn_fence(__ATOMIC_ACQUIRE, "agent");
            xb_add(&bar[XB_XGEN(b.x)], 1u);
            asm volatile("s_waitcnt vmcnt(0)" ::: "memory");
        } else {
            XB_SPIN(xb_ld(&bar[XB_XGEN(b.x)]) == gen, bar);
            __builtin_amdgcn_fence(__ATOMIC_ACQUIRE, "agent");
            asm volatile("s_waitcnt vmcnt(0)" ::: "memory");
        }
    }
    __syncthreads();
}

struct Args { const float* in[22]; float* out; unsigned char* ws; int ph_lo, ph_hi, coop, pad; };

__global__ void __launch_bounds__(512, 2) mk_fwd(Args args) {
    extern __shared__ __attribute__((aligned(16))) unsigned char lds_raw[];
    LAS unsigned char* lds = (LAS unsigned char*)lds_raw;
    const int tid = threadIdx.x, lane = tid & 63, wave = __builtin_amdgcn_readfirstlane(tid >> 6);
    const int G = gridDim.x, bx = blockIdx.x;
#define vcu ((G % 8 == 0) ? (bx % 8) * (G / 8) + bx / 8 : bx)
#define gw (wave * G + bx)
#define NGW (G * 8)
#define gt (bx * 512 + tid)
#define NGT (G * 512)
    unsigned char* ws = args.ws;
    const float* x = args.in[0]; const float* meta = args.in[1];
    float* out = args.out;
#define COS ((float*)(ws + WS_COS))
#define SIN ((float*)(ws + WS_SIN))
#define SSQ ((float*)(ws + WS_SSQ))
#define SSQC ((float*)(ws + WS_RSTD1))
#define RSTD1X ((float*)(ws + 128 * 1024))
#define RSTD2 ((float*)(ws + 256 * 1024))
#define RSTD3 ((float*)(ws + 320 * 1024))
#define RSTDQ ((float*)(ws + 384 * 1024))
#define RSTDKV ((float*)(ws + 448 * 1024))
#define A1M ((bf16_t*)(ws + WS_A1M))
#define ACT1M ((bf16_t*)(ws + WS_ACT1M))
#define D1MP ((float*)(ws + WS_D1MP))
#define A2M ((bf16_t*)(ws + WS_A2M))
#define ZLOM ((bf16_t*)(ws + WS_ZLOM))
#define KRM ((float*)(ws + WS_KRM))
#define CKVNM ((bf16_t*)(ws + WS_CKVNM))
#define KPE ((bf16_t*)(ws + WS_KPE))
#define WIN ((bf16_t*)(ws + WS_WIN))
#define WKR ((bf16_t*)(ws + WS_WKR))
#define PWS ((bf16_t*)(ws + WS_PWS))
#define WPO ((bf16_t*)(ws + WS_WPO))
#define WF ((bf16_t*)(ws + WS_WF))
#define WQB ((bf16_t*)(ws + WS_WQB))
#define WK ((bf16_t*)(ws + WS_WK))
#define WV ((bf16_t*)(ws + WS_WV))
#define WMO ((bf16_t*)(ws + WS_WMO))
#define WOUT ((bf16_t*)(ws + WS_WOUT))
#define WGU ((bf16_t*)(ws + WS_WGU))
#define WD ((bf16_t*)(ws + WS_WD))
#define DPOOL ((bf16_t*)(ws + WS_DPOOL))
#define CQKV ((bf16_t*)(ws + WS_CQN))
#define AB ((bf16_t*)(ws + WS_A))
#define ACT ((bf16_t*)(ws + WS_ACT))
#define D1 ((bf16_t*)(ws + WS_D1))
#define TB ((bf16_t*)(ws + WS_T))
#define ZLO ((bf16_t*)(ws + WS_ZLO))
#define KN ((bf16_t*)(ws + WS_KN))
#define VT ((bf16_t*)(ws + WS_VT))
#define QB ((bf16_t*)(ws + WS_Q))
#define YB ((bf16_t*)(ws + WS_Y))
#define MMB ((bf16_t*)(ws + WS_MM))
#define D2 ((bf16_t*)(ws + WS_D2))
#define ZG ((bf16_t*)out)
#define scr ((LAS float*)(lds + wave * 16384))

    const int lo = args.ph_lo, hi_ph = args.ph_hi;
    volatile LAS unsigned* bst = (volatile LAS unsigned*)(lds + 140000);
    if (tid < 2) bst[tid] = 0u;
    __syncthreads();
    XcdBarrier xbar; xbar.bar = (unsigned*)ws; xbar.x = 0; xbar.st = bst;
    if (args.coop) {
        if (bx == 0) { for (int i = tid; i < XCD_BAR_WORDS; i += 512) ((unsigned*)ws)[i] = 0u; }
        cg::this_grid().sync();
        xbar = xcd_barrier_post((unsigned*)ws, bst);
    }
#ifndef PHMASK
#define PHMASK 0x3fff
#endif
#define IN(k) (((PHMASK >> (k)) & 1) && lo <= (k) && (k) < hi_ph)
#define SEAM(k) do { if (args.coop && IN(k) && IN((k) + 1)) { xcd_barrier(xbar); if (DUP_SYNC) xcd_barrier(xbar); } } while (0)

    if (IN(0)) {
        int it = gw;
        conv_matrix(args.in[4], NGU, DM, NGU, 0, WGU, scr, lane, it, NGW, args.in[2]);
        conv_matrix(args.in[5], DM, DFF, DM, 1, WD, scr, lane, it, NGW);
        conv_matrix(args.in[8], 6208, DM, 6144, 2, WIN, scr, lane, it, NGW, args.in[6]);
        conv_matrix(args.in[8], 6208, DM, 64, 3, WKR, scr, lane, it, NGW, args.in[6]);
        conv_matrix(args.in[11], DM, 1024, DM, 1, WPO, scr, lane, it, NGW);
        conv_matrix(args.in[13], 3072, 512, 3072, 4, WQB, scr, lane, it, NGW, args.in[12]);
        conv_matrix(args.in[15], 4096, 512, 2048, 5, WK, scr, lane, it, NGW, args.in[14]);
        conv_matrix(args.in[15], 4096, 512, 2048, 6, WV, scr, lane, it, NGW, args.in[14]);
        conv_matrix(args.in[16], DM, DM, DM, 1, WMO, scr, lane, it, NGW);
        conv_matrix(args.in[17], DM, DM, DM, 1, WOUT, scr, lane, it, NGW);
        for (int i = gt; i < LP * 32; i += NGT) {
            const int pos = i >> 5, k = i & 31; double iv = 1.0;
            for (int q = 0; q < k; ++q) iv *= 0.7498942093324559;
            const float ang = (float)pos * (float)iv;
            const double xa = (double)ang; const double nq = __builtin_rint(xa * 0.6366197723675814);
            double r = __builtin_fma(-nq, 1.5707963109016418, xa); r = __builtin_fma(-nq, 1.5893254773528196e-08, r);
            const double r2 = r * r;
            double sp = 1.0 / 6227020800.0; sp = sp * r2 - 1.0 / 39916800.0; sp = sp * r2 + 1.0 / 362880.0; sp = sp * r2 - 1.0 / 5040.0; sp = sp * r2 + 1.0 / 120.0; sp = sp * r2 - 1.0 / 6.0; sp = sp * r2 + 1.0; sp *= r;
            double cp = -1.0 / 87178291200.0; cp = cp * r2 + 1.0 / 479001600.0; cp = cp * r2 - 1.0 / 3628800.0; cp = cp * r2 + 1.0 / 40320.0; cp = cp * r2 - 1.0 / 720.0; cp = cp * r2 + 1.0 / 24.0; cp = cp * r2 - 0.5; cp = cp * r2 + 1.0;
            const int qd = ((int)nq) & 3;
            const double sv = (qd == 0) ? sp : (qd == 1) ? cp : (qd == 2) ? -sp : -cp;
            const double cv = (qd == 0) ? cp : (qd == 1) ? -sp : (qd == 2) ? -cp : sp;
            COS[i] = (float)cv; SIN[i] = (float)sv;
        }
        for (int i = gt; i < 1024 * 256 / 2; i += NGT) { const int e = 2 * i, g = e >> 16, j = e & 255;
            const f32x2 w = *(const f32x2*)(args.in[9] + e); const f32x2 s = *(const f32x2*)(args.in[10] + g * 256 + j);
            *(unsigned*)(PWS + e) = pk2(w.x * s.x, w.y * s.y); }
        for (int m = gw; m < M + NMETA; m += NGW) {
            f32x4 v[8]; const bool ism = m >= M; ld_row_f32(ism ? meta + (size_t)(m - M) * DM : x + (size_t)m * DM, lane, v);
            const float rstd = rsqrtf(row_ssq(v) * (1.f / DM) + EPS);
            if (ism) st_row_scaled_bf16(A1M + (size_t)(m - M) * DM, v, rstd, lane);
            else { st_row_bf16(AB + (size_t)m * DM, v, lane); if (lane == 0) RSTD1X[m] = rstd; }
        }
    }
    SEAM(0);
    if (IN(1)) {
        pg8::Gemm g{AB, WGU, DM, DM, DM, 0, 30, 0, M / 256, NGU / 256};
        pg8::EpiSwiGLU E{ACT, RSTD1X};
        pg8::gemm_phase(lds, g, G, bx, E);
        if (DUP_P1) pg8::gemm_phase(lds, g, G, bx, E);
        for (int it = gw; it < DFF / 16; it += NGW) {
            const int c0 = 16 * it, wrow = 256 * (c0 >> 7) + (c0 & 127);
            f32x4 acc[1][2]; skinny<1, 2>(A1M, DM, WGU + (size_t)wrow * DM, DM, 128, DM, acc, lane);
            const int fr = lane & 15, fq = lane >> 4; u32x2 w;
            w.x = pk2(fsilu(acc[0][0][0]) * acc[0][1][0], fsilu(acc[0][0][1]) * acc[0][1][1]); w.y = pk2(fsilu(acc[0][0][2]) * acc[0][1][2], fsilu(acc[0][0][3]) * acc[0][1][3]);
            *(u32x2*)(ACT1M + (size_t)fr * DFF + c0 + 4 * fq) = w;
        }
    }
    SEAM(1);
    if (IN(2)) {
        pg8::Gemm g{ACT, WD, DFF, DFF, DFF, 0, 30, 0, M / 256, DM / 256};
        pg8::EpiSsq E{D1, SSQ};
        pg8::gemm_phase(lds, g, G, bx, E);
        for (int it = gw; it < 512; it += NGW) {
            const int cb = it & 127, ks = it >> 7;
            f32x4 acc[1][1]; skinny<1, 1>(ACT1M + ks * 1408, DFF, WD + (size_t)(16 * cb) * DFF + ks * 1408, DFF, 16, 1408, acc, lane);
            const int fr = lane & 15, fq = lane >> 4;
            *(f32x4*)(D1MP + (size_t)ks * 16 * DM + (size_t)fr * DM + 16 * cb + 4 * fq) = acc[0][0];
        }
    }
    SEAM(2);
    if (IN(3)) {
        for (int it = gw; it < 2048; it += NGW) {
            const int n0 = (it >> 4) * 16, g = (it >> 2) & 3, cq = it & 3, fr = lane & 15, fq = lane >> 4;
            f32x4 acc[1][4]; skinny<1, 4>(WPO + (size_t)n0 * 1024 + 256 * g, 1024, PWS + (size_t)(256 * g + 64 * cq) * 256, 256, 16, 256, acc, lane);
#pragma unroll
            for (int cb = 0; cb < 4; ++cb) { u32x2 w; w.x = pk2(acc[0][cb][0], acc[0][cb][1]); w.y = pk2(acc[0][cb][2], acc[0][cb][3]);
                *(u32x2*)(WF + (size_t)(n0 + fr) * 1024 + 256 * g + 64 * cq + 16 * cb + 4 * fq) = w; }
        }
#ifndef NO_P3ROWS
        f32x4 gp3[8]; ld_row_f32(args.in[3], lane, gp3);
        for (int m = gw; m < M + NMETA; m += NGW) {
            f32x4 v[8], d[8]; const bool ism = m >= M; float rstd1;
            if (!ism) {
                ld_row_bf16(AB + (size_t)m * DM, lane, v); ld_row_bf16(D1 + (size_t)m * DM, lane, d);
                const float ss = wave_sum(lane < 32 ? SSQ[(size_t)m * 32 + lane] : 0.f);
                rstd1 = rsqrtf(ss * (1.f / DM) + EPS);
            } else {
                const int mm = m - M; ld_row_f32(meta + (size_t)mm * DM, lane, v);
                ld_row_f32(D1MP + (size_t)mm * DM, lane, d);
                for (int ks = 1; ks < 4; ++ks) {
#pragma unroll
                    for (int j = 0; j < 8; ++j) d[j] += *(const f32x4*)(D1MP + (size_t)ks * 16 * DM + (size_t)mm * DM + 4 * lane + 256 * j);
                    asm volatile("" ::: "memory"); }
                rstd1 = rsqrtf(row_ssq(d) * (1.f / DM) + EPS);
            }
            add_normed_g(v, d, 0.5f * rstd1, gp3);
            if (!ism) st_row_bf16(D1 + (size_t)m * DM, v, lane);
            const float rstd = rsqrtf(row_ssq(v) * (1.f / DM) + EPS);
            if (ism) st_row_scaled_bf16(A2M + (size_t)(m - M) * DM, v, rstd, lane);
            else if (lane == 0) RSTD2[m] = rstd;
        }
#endif
    }
    SEAM(3);
    if (IN(4)) {
        pg8::Gemm g{D1, WIN, DM, DM, DM, 0, 30, 0, M / 256, 6144 / 256};
        pg8::EpiWin E{ZLO, CQKV, ZG, SSQC, RSTD2};
        pg8::gemm_phase(lds, g, G, bx, E);
        for (int it = gw; it < 100; it += NGW) {
            const bf16_t* w; int ocol; bool kr = false;
            if (it < 64) { w = WIN + (size_t)(16 * it) * DM; ocol = 16 * it; }
            else if (it < 96) { w = WIN + (size_t)(1536 + 16 * (it - 64)) * DM; ocol = 1536 + 16 * (it - 64); }
            else { w = WKR + (size_t)(16 * (it - 96)) * DM; ocol = 16 * (it - 96); kr = true; }
            f32x4 acc[1][1]; skinny<1, 1>(A2M, DM, w, DM, 16, DM, acc, lane);
            const int fr = lane & 15, fq = lane >> 4;
            if (kr) *(f32x4*)(KRM + fr * 64 + ocol + 4 * fq) = acc[0][0];
            else { u32x2 o; o.x = pk2(acc[0][0][0], acc[0][0][1]); o.y = pk2(acc[0][0][2], acc[0][0][3]); *(u32x2*)(ZLOM + (size_t)fr * DM + ocol + 4 * fq) = o; }
        }
    }
    SEAM(4);
    if (IN(5)) {
        for (int it = gw; it < M / 32; it += NGW) {
            f32x4 acc[2][4]; skinny<2, 4>(D1 + (size_t)(32 * it) * DM, DM, WKR, DM, 16, DM, acc, lane);
            const int fr = lane & 15, fq = lane >> 4;
#pragma unroll
            for (int rb = 0; rb < 2; ++rb) { const int row = 32 * it + 16 * rb + fr; const int pos = NMETA + (row & (SEQ - 1)); const size_t kr = (size_t)(row >> 12) * LP + pos; const float rs = RSTD2[row];
#pragma unroll
                for (int cb = 0; cb < 2; ++cb) { const int dd = 16 * cb + 4 * fq; const f32x4 c = *(const f32x4*)(COS + pos * 32 + dd), s = *(const f32x4*)(SIN + pos * 32 + dd);
                    const f32x4 x1 = acc[rb][cb] * rs, x2 = acc[rb][cb + 2] * rs; const f32x4 o1 = x1 * c - x2 * s, o2 = x2 * c + x1 * s;
                    u32x2 w; w.x = pk2(o1[0], o1[1]); w.y = pk2(o1[2], o1[3]); *(u32x2*)(KPE + kr * 64 + dd) = w;
                    w.x = pk2(o2[0], o2[1]); w.y = pk2(o2[2], o2[3]); *(u32x2*)(KPE + kr * 64 + 32 + dd) = w; } }
        }
        if (gw == NGW - 1) {
            for (int p = 0; p < NMETA; ++p) if (lane < 32) { const float x1 = KRM[p * 64 + lane], x2 = KRM[p * 64 + 32 + lane]; const float c = COS[p * 32 + lane], s = SIN[p * 32 + lane];
                const float o1 = x1 * c - x2 * s, o2 = x2 * c + x1 * s;
                for (int b = 0; b < NB; ++b) { KPE[((size_t)b * LP + p) * 64 + lane] = (bf16_t)(pk2(o1, 0.f) & 0xffff); KPE[((size_t)b * LP + p) * 64 + 32 + lane] = (bf16_t)(pk2(o2, 0.f) & 0xffff); } }
        }
        for (int m = gt; m < M; m += NGT) { const f32x4* p = (const f32x4*)(SSQC + (size_t)m * 16); const f32x4 a = p[0], b2 = p[1], c = p[2], d = p[3];
            RSTDQ[m] = rsqrtf(((a[0] + a[1]) + (a[2] + a[3]) + (b2[0] + b2[1]) + (b2[2] + b2[3])) * (1.f / 512) + EPS);
            RSTDKV[m] = rsqrtf(((c[0] + c[1]) + (c[2] + c[3]) + (d[0] + d[1]) + (d[2] + d[3])) * (1.f / 512) + EPS); }
        for (int mm = gw; mm < NMETA; mm += NGW) {
            float f[8]; unpack8(*(const u32x4*)(ZLOM + (size_t)mm * DM + 1536 + 8 * lane), f); float ss = 0.f;
#pragma unroll
            for (int j = 0; j < 8; ++j) ss += f[j] * f[j];
            const float rstd = rsqrtf(wave_sum(ss) * (1.f / 512) + EPS);
            u32x4 w; w.x = pk2(f[0] * rstd, f[1] * rstd); w.y = pk2(f[2] * rstd, f[3] * rstd); w.z = pk2(f[4] * rstd, f[5] * rstd); w.w = pk2(f[6] * rstd, f[7] * rstd);
            *(u32x4*)(CKVNM + (size_t)mm * 512 + 8 * lane) = w;
        }
        for (int it = gw; it < (M / 16) * 2; it += NGW) {
            const int rc = it >> 1, hf = it & 1, row0 = rc * 16, b = row0 >> 12, s0 = row0 & (SEQ - 1), c0 = hf * 512 + 8 * lane;
            const int w = 2 << (c0 >> 8); const float invw = 1.f / (float)w;
            float sum[8];
#pragma unroll
            for (int j = 0; j < 8; ++j) sum[j] = 0.f;
#define POOL_LD(s_, f_) do { const int ss_ = (s_); const bf16_t* p_ = ss_ >= 0 ? ZLO + ((size_t)b * SEQ + ss_) * DM + c0 : ZLOM + (size_t)(NMETA + ss_) * DM + c0; unpack8(*(const u32x4*)p_, f_); } while (0)
#define POOL_PTR(s_) ((s_) >= 0 ? ZLO + ((size_t)b * SEQ + (s_)) * DM + c0 : ZLOM + (size_t)(NMETA + (s_)) * DM + c0)
            u32x4 wu[15], cu[16], ol[16];
#pragma unroll
            for (int j = 1; j < 16; ++j) { wu[j - 1] = (u32x4){0u, 0u, 0u, 0u}; if (j < w) wu[j - 1] = *(const u32x4*)POOL_PTR(s0 - j); }
#pragma unroll
            for (int i = 0; i < 16; ++i) { cu[i] = *(const u32x4*)POOL_PTR(s0 + i); ol[i] = *(const u32x4*)POOL_PTR(s0 + i - w + 1); }
#pragma unroll
            for (int j = 0; j < 15; ++j) { float f[8]; unpack8(wu[j], f);
#pragma unroll
                for (int e = 0; e < 8; ++e) sum[e] += f[e]; }
#pragma unroll
            for (int i = 0; i < 16; ++i) { float cur[8], old[8]; unpack8(cu[i], cur); unpack8(ol[i], old);
                float o[8];
#pragma unroll
                for (int e = 0; e < 8; ++e) { sum[e] += cur[e]; o[e] = sum[e] * invw - cur[e]; sum[e] -= old[e]; }
                u32x4 wv; wv.x = pk2(o[0], o[1]); wv.y = pk2(o[2], o[3]); wv.z = pk2(o[4], o[5]); wv.w = pk2(o[6], o[7]);
                *(u32x4*)(DPOOL + (size_t)(row0 + i) * 1024 + c0) = wv; }
#undef POOL_PTR
#undef POOL_LD
        }
    }
    SEAM(5);
    if (IN(6)) {
        { const u32x4 z = {0u, 0u, 0u, 0u};
          for (int i = gt; i < NB * 48 * 256; i += NGT) { const int b = i / (48 * 256), r = (i / 256) % 48, c = i % 256; *(u32x4*)(KN + ((size_t)b * LP + 4112 + r) * DM + c * 8) = z; }
          for (int i = gt; i < NB * DM * 6; i += NGT) { const int rr = i / 6, c = i % 6; *(u32x4*)(VT + vt_idx(rr >> 11, rr & 2047, 4112 + c * 8)) = z; }
          for (int i = gt; i < NB * 48 * 8; i += NGT) { const int b = i / (48 * 8), r = (i / 8) % 48, c = i % 8; *(u32x4*)(KPE + ((size_t)b * LP + 4112 + r) * 64 + c * 8) = z; } }
        if (bx & 1) {
            { pg8::Gemm g{DPOOL, WF, 1024, 1024, 1024, 0, 30, 0, M / 256, DM / 256}; pg8::EpiGate1 E{TB, ZG}; pg8::gemm_phase(lds, g, G, bx, E); }
            { pg8::Gemm g{WV, CQKV + 512, 512, 1024, 512, 0, 30, 0, DM / 256, M / 256}; pg8::EpiVt E{VT, RSTDKV}; pg8::gemm_phase(lds, g, G, bx, E); }
            { pg8::Gemm g{CQKV + 512, WK, 1024, 512, 512, 0, 30, 0, M / 256, DM / 256}; pg8::EpiKn E{KN, RSTDKV}; pg8::gemm_phase(lds, g, G, bx, E); }
            { pg8::Gemm g{CQKV, WQB, 1024, 512, 512, 0, 30, 0, M / 256, 3072 / 256}; pg8::EpiQ E{QB, COS, SIN, RSTDQ}; pg8::gemm_phase(lds, g, G, bx, E); }
        } else {
            { pg8::Gemm g{CQKV, WQB, 1024, 512, 512, 0, 30, 0, M / 256, 3072 / 256}; pg8::EpiQ E{QB, COS, SIN, RSTDQ}; pg8::gemm_phase(lds, g, G, bx, E); }
            { pg8::Gemm g{CQKV + 512, WK, 1024, 512, 512, 0, 30, 0, M / 256, DM / 256}; pg8::EpiKn E{KN, RSTDKV}; pg8::gemm_phase(lds, g, G, bx, E); }
            { pg8::Gemm g{WV, CQKV + 512, 512, 1024, 512, 0, 30, 0, DM / 256, M / 256}; pg8::EpiVt E{VT, RSTDKV}; pg8::gemm_phase(lds, g, G, bx, E); }
            { pg8::Gemm g{DPOOL, WF, 1024, 1024, 1024, 0, 30, 0, M / 256, DM / 256}; pg8::EpiGate1 E{TB, ZG}; pg8::gemm_phase(lds, g, G, bx, E); }
        }
        for (int it = gw; it < 256; it += NGW) {
            const int fr = lane & 15, fq = lane >> 4; f32x4 acc[1][1];
            if (it < 128) { skinny<1, 1>(CKVNM, 512, WK + (size_t)(16 * it) * 512, 512, 16, 512, acc, lane);
                u32x2 w; w.x = pk2(acc[0][0][0], acc[0][0][1]); w.y = pk2(acc[0][0][2], acc[0][0][3]);
                for (int b = 0; b < NB; ++b) *(u32x2*)(KN + ((size_t)b * LP + fr) * DM + 16 * it + 4 * fq) = w;
            } else { const int i2 = it - 128; skinny<1, 1>(CKVNM, 512, WV + (size_t)(16 * i2) * 512, 512, 16, 512, acc, lane);
                for (int b = 0; b < NB; ++b)
#pragma unroll
                    for (int j = 0; j < 4; ++j) VT[vt_idx(b, 16 * i2 + 4 * fq + j, fr)] = (bf16_t)(pk2(acc[0][0][j], 0.f) & 0xffff); }
        }
    }
    SEAM(6);
    if (IN(7)) {
#ifndef NO_ATTN
        for (int v = vcu; v < 256; v += G) {
            const int bh = v >> 2, j = v & 3, b = bh >> 4, h = bh & 15;
#if DUP_ATTN
            attn_unit(b, h, 15 - j, QB, DPOOL, DM, 128, KN, KPE, VT, lds);
            attn_unit(b, h, 8 + j, QB, DPOOL, DM, 128, KN, KPE, VT, lds);
            attn_unit(b, h, 7 - j, QB, DPOOL, DM, 128, KN, KPE, VT, lds);
            attn_unit(b, h, j, QB, DPOOL, DM, 128, KN, KPE, VT, lds);
#endif
#pragma clang loop unroll(disable)
            for (int ui = 0; ui < 4; ++ui) { const int qb = (ui == 0) ? 15 - j : (ui == 1) ? 8 + j : (ui == 2) ? 7 - j : j;
                attn_unit(b, h, qb, QB, QB, QW, 192, KN, KPE, VT, lds); }
        }
#endif
    }
    SEAM(7);
    if (IN(8)) {
        pg8::Gemm g{QB, WMO, QW, DM, DM, 0, 1, 384, M / 256, DM / 256};
        pg8::EpiGate2 E{YB, TB, ZG};
        pg8::gemm_phase(lds, g, G, bx, E);
    }
    SEAM(8);
    if (IN(9)) {
        pg8::Gemm g{YB, WOUT, DM, DM, DM, 0, 30, 0, M / 256, DM / 256};
        pg8::EpiSsq E{MMB, SSQ};
        pg8::gemm_phase(lds, g, G, bx, E);
    }
    SEAM(9);
    if (IN(10)) {
        { int it = gw;
          conv_matrix(args.in[20], NGU, DM, NGU, 0, WGU, scr, lane, it, NGW, args.in[18]);
          conv_matrix(args.in[21], DM, DFF, DM, 1, WD, scr, lane, it, NGW); }
        f32x4 gp10[8]; ld_row_f32(args.in[7], lane, gp10);
        for (int m = gw; m < M; m += NGW) {
            f32x4 v[8], d[8]; ld_row_bf16(D1 + (size_t)m * DM, lane, v);
            ld_row_bf16(MMB + (size_t)m * DM, lane, d);
            const float ss = wave_sum(lane < 32 ? SSQ[(size_t)m * 32 + lane] : 0.f);
            add_normed_g(v, d, rsqrtf(ss * (1.f / DM) + EPS), gp10);
            st_row_bf16(TB + (size_t)m * DM, v, lane);
            const float rstd = rsqrtf(row_ssq(v) * (1.f / DM) + EPS);
            if (lane == 0) RSTD3[m] = rstd;
        }
    }
    SEAM(10);
    if (IN(11)) {
        pg8::Gemm g{TB, WGU, DM, DM, DM, 0, 30, 0, M / 256, NGU / 256};
        pg8::EpiSwiGLU E{ACT, RSTD3};
        pg8::gemm_phase(lds, g, G, bx, E);
    }
    SEAM(11);
    if (IN(12)) {
        pg8::Gemm g{ACT, WD, DFF, DFF, DFF, 0, 30, 0, M / 256, DM / 256};
        pg8::EpiSsq E{D2, SSQ};
        pg8::gemm_phase(lds, g, G, bx, E);
    }
    SEAM(12);
    if (IN(13)) {
        f32x4 gp13[8]; ld_row_f32(args.in[19], lane, gp13);
        for (int m = gw; m < M; m += NGW) {
            f32x4 v[8], d[8]; ld_row_bf16(TB + (size_t)m * DM, lane, v); ld_row_bf16(D2 + (size_t)m * DM, lane, d);
            const float ss = wave_sum(lane < 32 ? SSQ[(size_t)m * 32 + lane] : 0.f);
            add_normed_g(v, d, 0.5f * rsqrtf(ss * (1.f / DM) + EPS), gp13);
#pragma unroll
            for (int j = 0; j < 8; ++j) *(f32x4*)(out + (size_t)m * DM + 4 * lane + 256 * j) = v[j];
        }
    }
#undef IN
#undef SEAM
#undef vcu
#undef gw
#undef NGW
#undef gt
#undef NGT
#undef scr
#undef COS
#undef SIN
#undef SSQ
#undef SSQC
#undef RSTD1X
#undef RSTD2
#undef RSTD3
#undef RSTDQ
#undef RSTDKV
#undef A1M
#undef ACT1M
#undef D1MP
#undef A2M
#undef ZLOM
#undef KRM
#undef CKVNM
#undef KPE
#undef WIN
#undef WKR
#undef PWS
#undef WPO
#undef WF
#undef WQB
#undef WK
#undef WV
#undef WMO
#undef WOUT
#undef WGU
#undef WD
#undef DPOOL
#undef CQKV
#undef AB
#undef ACT
#undef D1
#undef TB
#undef ZLO
#undef KN
#undef VT
#undef QB
#undef YB
#undef MMB
#undef D2
#undef ZG
}

extern "C" void kernel_launch(void* const* d_in, const int* in_sizes, int n_in, void* d_out, int out_size, void* d_ws, size_t ws_size, hipStream_t stream) {
    static int grid = 0;
    if (grid == 0) {
        if (n_in != 22 || out_size != M * DM || ws_size < WS_END) { fprintf(stderr, "kernel_launch: unexpected shapes (n_in %d out %d ws %zu)\n", n_in, out_size, ws_size); grid = -1; return; }
        int dev = 0, cus = 0, per_cu = 0;
        hipGetDevice(&dev); hipDeviceGetAttribute(&cus, hipDeviceAttributeMultiprocessorCount, dev);
        if (hipFuncSetAttribute((const void*)mk_fwd, hipFuncAttributeMaxDynamicSharedMemorySize, LDS_BYTES) != hipSuccess) { fprintf(stderr, "kernel_launch: hipFuncSetAttribute failed\n"); }
        if (hipOccupancyMaxActiveBlocksPerMultiprocessor(&per_cu, (const void*)mk_fwd, 512, LDS_BYTES) != hipSuccess || per_cu < 1) fprintf(stderr, "kernel_launch: occupancy query says %d\n", per_cu);
        (void)hipGetLastError();
        grid = cus > 0 ? cus : 256;
        if (grid > 256) grid = 256;
        grid -= grid % 8;
    }
    if (grid <= 0) return;
    Args a{};
    for (int i = 0; i < 22; ++i) a.in[i] = (const float*)d_in[i];
    a.out = (float*)d_out; a.ws = (unsigned char*)d_ws;
#if MK_SINGLE
    a.ph_lo = 0; a.ph_hi = NPH; a.coop = 1;
    void* kargs[] = {&a};
    hipError_t e = hipLaunchCooperativeKernel((const void*)mk_fwd, dim3(grid), dim3(512), kargs, LDS_BYTES, stream);
    if (e != hipSuccess) fprintf(stderr, "cooperative launch failed: %s (grid %d)\n", hipGetErrorString(e), grid);
#else
    for (int ph = 0; ph < NPH; ++ph) { a.ph_lo = ph; a.ph_hi = ph + 1; a.coop = 0; hipLaunchKernelGGL(mk_fwd, dim3(grid), dim3(512), LDS_BYTES, stream, a); }
#endif
}
```

```cpp
#include <hip/hip_runtime.h>
#include <hip/hip_cooperative_groups.h>
#include <cstdio>
#include <cstdint>
namespace cg = cooperative_groups;

#ifndef MK_SINGLE
#define MK_SINGLE 1
#endif

#ifndef DUP_ATTN
#define DUP_ATTN 0
#endif
#ifndef DUP_SYNC
#define DUP_SYNC 0
#endif
#ifndef DUP_P1
#define DUP_P1 0
#endif
#ifndef DUP_EW
#define DUP_EW 0
#endif
#define LAS __attribute__((address_space(3)))
typedef unsigned short bf16_t;
typedef short bf16x8 __attribute__((ext_vector_type(8)));
typedef float f32x4 __attribute__((ext_vector_type(4)));
typedef float f32x16 __attribute__((ext_vector_type(16)));
typedef unsigned u32x4 __attribute__((ext_vector_type(4)));
typedef unsigned u32x2 __attribute__((ext_vector_type(2)));
typedef float f32x2 __attribute__((ext_vector_type(2)));
typedef __bf16 bf16x2_t __attribute__((ext_vector_type(2)));

constexpr int M = 16384, DM = 2048, DFF = 5632, NGU = 2 * DFF, SEQ = 4096, NB = 4, NMETA = 16, LP = 4160, NH = 16;
constexpr int QW = 3072;
constexpr float EPS = 1e-6f;
constexpr float QSCALE = 0.10411754627697264f;
constexpr int NPH = 14;

constexpr size_t MiB = 1u << 20;
constexpr size_t WS_COS = 1 * MiB, WS_SIN = 2 * MiB, WS_SSQ = 3 * MiB, WS_RSTD1 = 5 * MiB;
constexpr size_t WS_A1M = 6 * MiB, WS_ACT1M = 6 * MiB + 256 * 1024, WS_D1MP = 6 * MiB + 512 * 1024  , WS_A2M = 7 * MiB + 256 * 1024,
                 WS_ZLOM = 7 * MiB + 512 * 1024, WS_KRM = 7 * MiB + 768 * 1024, WS_CKVNM = 7 * MiB + 832 * 1024;
constexpr size_t WS_KPE = 8 * MiB;
constexpr size_t WS_WIN = 11 * MiB, WS_WKR = 35 * MiB, WS_PWS = 35 * MiB + 512 * 1024, WS_WPO = 36 * MiB, WS_WF = 40 * MiB, WS_WQB = 44 * MiB,
                 WS_WK = 47 * MiB, WS_WV = 49 * MiB, WS_WMO = 51 * MiB, WS_WOUT = 59 * MiB;
constexpr size_t WS_WGU = 67 * MiB, WS_WD = 111 * MiB;
constexpr size_t WS_DPOOL = 67 * MiB, WS_CQN = 99 * MiB, WS_CKVN = 115 * MiB;
constexpr size_t WS_A = 133 * MiB, WS_ACT = 197 * MiB, WS_D1 = 373 * MiB, WS_T = 437 * MiB;
constexpr size_t WS_ZLO = 197 * MiB;
constexpr size_t WS_KN = 133 * MiB, WS_VT = 198 * MiB, WS_Q = 263 * MiB;
constexpr size_t WS_Y = 133 * MiB, WS_MM = 197 * MiB, WS_D2 = 373 * MiB;
constexpr size_t WS_END = 501 * MiB;

constexpr int LDS_BYTES = 147456;

__device__ __forceinline__ unsigned pk2(float lo, float hi) { f32x2 v = {lo, hi}; bf16x2_t b = __builtin_convertvector(v, bf16x2_t); return __builtin_bit_cast(unsigned, b); }
__device__ __forceinline__ float bflo(unsigned u) { return __uint_as_float(u << 16); }
__device__ __forceinline__ float bfhi(unsigned u) { return __uint_as_float(u & 0xffff0000u); }
__device__ __forceinline__ float wave_sum(float v) {
#pragma unroll
    for (int o = 1; o < 64; o <<= 1) v += __shfl_xor(v, o);
    return v;
}
__device__ __forceinline__ float fsigmoid(float x) { return __builtin_amdgcn_rcpf(1.f + __expf(-x)); }
__device__ __forceinline__ float fsilu(float x) { return x * fsigmoid(x); }
__device__ __forceinline__ u32x4 pack8(const f32x4 a, const f32x4 b) { u32x4 w; w.x = pk2(a[0], a[1]); w.y = pk2(a[2], a[3]); w.z = pk2(b[0], b[1]); w.w = pk2(b[2], b[3]); return w; }
__device__ __forceinline__ void unpack8(const u32x4 w, float (&f)[8]) {
    f[0] = bflo(w.x); f[1] = bfhi(w.x); f[2] = bflo(w.y); f[3] = bfhi(w.y); f[4] = bflo(w.z); f[5] = bfhi(w.z); f[6] = bflo(w.w); f[7] = bfhi(w.w);
}

__device__ __forceinline__ size_t vt_idx(int b, int r, int pos) { return ((((size_t)(b * NH + (r >> 7)) * 65 + (pos >> 6)) * 128 + (r & 127)) << 6) + (pos & 63); }

namespace pg8 {
constexpr int BM = 256, BK = 64, HALF = 128, HTB = HALF * BK * 2, STAGE_BYTES = 8 * HTB, NXCD = 8, WGM = 4;
__host__ __device__ __forceinline__ int lds_byte(int r, int c) { const int st = (r >> 4) * 2 + (c >> 5), rr = r & 15, cc = c & 31, ob = rr * 64 + cc * 2; return st * 1024 + (ob ^ (((ob >> 9) & 1) << 5)); }
__host__ __device__ __forceinline__ void stage_rc(int b, int& R, int& C) { const int st = b / 1024, sb = b % 1024, swz = sb ^ (((sb >> 9) & 1) << 5); R = (st >> 1) * 16 + swz / 64; C = (st & 1) * 32 + (swz % 64) / 2; }
__host__ __device__ __forceinline__ int perm32(int rho) { const int n = rho >> 4, i = rho & 15; return 8 * (i >> 2) + 4 * n + (i & 3); }

struct Unit { int pm, pn; };
struct Gemm { const bf16_t* A; const bf16_t* Bt; int lda, ldb, K, a_pn_off, kshift, kbig, nM, nN; };

struct StaticOrder {
    int nM, nN, nwg, G, c;
    __device__ void init(int nM_, int nN_, int G_, int c_) { nM = nM_; nN = nN_; nwg = nM * nN; G = G_; c = c_; }
    __device__ bool next(int i, Unit& u) const {
        const long L = (long)i * G + c; if (L >= nwg) return false;
        int wgid = (int)L; { const int q = nwg / NXCD, r = nwg % NXCD, xcd = wgid % NXCD, off = wgid / NXCD; wgid = (xcd < r ? xcd * (q + 1) : r * (q + 1) + (xcd - r) * q) + off; }
        const int nig = WGM * nN, gid = wgid / nig, fm = gid * WGM, gsz = (nM - fm) < WGM ? (nM - fm) : WGM;
        u.pm = fm + ((wgid % nig) % gsz); u.pn = (wgid % nig) / gsz; return true;
    }
};

template <class Epi>
__device__ __forceinline__ void gemm_phase(LAS unsigned char* lds, const Gemm g, const int G, const int cidx, const Epi E) {
    const int tid = threadIdx.x, wid = __builtin_amdgcn_readfirstlane(tid >> 6), lane = tid & 63, wr = wid >> 2, wc = wid & 3, fr = lane & 15, fq = lane >> 4;
    const int K = g.K, nt = K / BK;
    StaticOrder S; S.init(g.nM, g.nN, G, cidx);
    unsigned voffA[2], voffB[2];
#pragma unroll
    for (int i = 0; i < 2; ++i) { int R, C; stage_rc(tid * 16 + i * 8192, R, C); const int Rb = (R & ~31) + perm32(R & 31);
        voffA[i] = (unsigned)(R * g.lda + C) * 2u; voffB[i] = (unsigned)(Rb * g.ldb + C) * 2u; }
    const size_t kstep = (size_t)(BK * 2);
    const size_t hstepA = (size_t)HALF * g.lda * 2, tstepA = 2 * hstepA;
    const size_t hstepB = (size_t)HALF * g.ldb * 2, tstepB = 2 * hstepB;
    const unsigned ldsw = (unsigned)wid * 1024u;
    const int aoff = lds_byte(wr * 64 + fr, fq * 8), boff = lds_byte(wc * 32 + fr, fq * 8);
#define PG8_KOA(t) (g.kshift >= 30 ? (size_t)(t) * 128 : (size_t)((t) >> g.kshift) * (size_t)g.kbig + (size_t)((t) & ((1 << g.kshift) - 1)) * 128)
#define PG8_SA(b, h) (((b) * 2 + (h)) * HTB)
#define PG8_SB(b, h) ((4 + (b) * 2 + (h)) * HTB)
#define PG8_STAGE(bufoff, gbase, voff) do { _Pragma("unroll") for (int _i = 0; _i < 2; ++_i) \
        __builtin_amdgcn_global_load_lds((const unsigned*)((const char*)(gbase) + (voff)[_i]), (LAS unsigned*)(lds + (bufoff) + ldsw + _i * 8192), 16, 0, 0); } while (0)
#define PG8_LDA(dst, b, h) do { _Pragma("unroll") for (int m = 0; m < 4; ++m) _Pragma("unroll") for (int k = 0; k < 2; ++k) dst[m][k] = *(const LAS bf16x8*)(lds + PG8_SA(b, h) + aoff + m * 2048 + k * 1024); } while (0)
#define PG8_LDB(dst, b, h) do { _Pragma("unroll") for (int n = 0; n < 2; ++n) _Pragma("unroll") for (int k = 0; k < 2; ++k) dst[n][k] = *(const LAS bf16x8*)(lds + PG8_SB(b, h) + boff + n * 2048 + k * 1024); } while (0)
#define PG8_MMA(ai, bj, At, Bt) do { __builtin_amdgcn_s_setprio(1); _Pragma("unroll") for (int m = 0; m < 4; ++m) _Pragma("unroll") for (int n = 0; n < 2; ++n) _Pragma("unroll") for (int k = 0; k < 2; ++k) \
        acc[ai][bj][m][n] = __builtin_amdgcn_mfma_f32_16x16x32_bf16(Bt[n][k], At[m][k], acc[ai][bj][m][n], 0, 0, 0); __builtin_amdgcn_s_setprio(0); } while (0)
#define PG8_WAIT_V(n) asm volatile("s_waitcnt vmcnt(" #n ")" ::: "memory")
#define PG8_WAIT_L(n) asm volatile("s_waitcnt lgkmcnt(" #n ")" ::: "memory")
#define PG8_BAR __builtin_amdgcn_s_barrier()
#define PG8_SCHED __builtin_amdgcn_sched_barrier(0)
    Unit cur, nxt; int ui = 0;
    if (!S.next(0, cur)) return;
    f32x4 acc[2][2][4][2];
#pragma unroll
    for (int a = 0; a < 2; ++a)
#pragma unroll
        for (int b = 0; b < 2; ++b)
#pragma unroll
            for (int m = 0; m < 4; ++m)
#pragma unroll
                for (int n = 0; n < 2; ++n) acc[a][b][m][n] = (f32x4){0.f, 0.f, 0.f, 0.f};
    bf16x8 At[4][2], B0[2][2], B1[2][2];
    const char* cA = (const char*)g.A + (size_t)cur.pm * tstepA + (size_t)cur.pn * (size_t)g.a_pn_off; const char* cB = (const char*)g.Bt + (size_t)cur.pn * tstepB;
    {
        PG8_STAGE(PG8_SB(0, 0), cB, voffB); PG8_STAGE(PG8_SB(0, 1), cB + hstepB, voffB); PG8_STAGE(PG8_SA(0, 0), cA, voffA); PG8_STAGE(PG8_SA(0, 1), cA + hstepA, voffA);
        if (wr == 1) PG8_BAR;
        PG8_WAIT_V(2); PG8_BAR;
        PG8_STAGE(PG8_SB(1, 0), cB + kstep, voffB); PG8_STAGE(PG8_SA(1, 0), cA + PG8_KOA(1), voffA); PG8_STAGE(PG8_SB(1, 1), cB + hstepB + kstep, voffB);
        PG8_WAIT_V(6); PG8_BAR;
    }
    for (;;) {
        const bool has_next = S.next(ui + 1, nxt);
        const char* nA = has_next ? (const char*)g.A + (size_t)nxt.pm * tstepA + (size_t)nxt.pn * (size_t)g.a_pn_off : cA; const char* nB = has_next ? (const char*)g.Bt + (size_t)nxt.pn * tstepB : cB;
#pragma clang loop unroll(disable)
        for (int t = 0; t < nt; t += 2) {
            const bool last = (t == nt - 2);
            const char* a1 = cA + PG8_KOA(t + 1);
            const char* a2 = last ? nA : cA + PG8_KOA(t + 2); const char* b2 = last ? nB : cB + (size_t)(t + 2) * kstep;
            const char* a3 = last ? nA + PG8_KOA(1) : cA + PG8_KOA(t + 3); const char* b3 = b2 + kstep;
            PG8_LDB(B0, 0, 0); PG8_LDB(B1, 0, 1); PG8_SCHED; PG8_LDA(At, 0, 0); PG8_STAGE(PG8_SA(1, 1), a1 + hstepA, voffA);
            PG8_WAIT_V(8); PG8_WAIT_L(0); PG8_BAR; PG8_MMA(0, 0, At, B0); PG8_MMA(0, 1, At, B1); PG8_BAR; PG8_SCHED;
            PG8_LDA(At, 0, 1); PG8_STAGE(PG8_SB(0, 0), b2, voffB); PG8_STAGE(PG8_SB(0, 1), b2 + hstepB, voffB); PG8_STAGE(PG8_SA(0, 0), a2, voffA);
            PG8_WAIT_V(8); PG8_WAIT_L(0); PG8_BAR; PG8_MMA(1, 0, At, B0); PG8_MMA(1, 1, At, B1); PG8_BAR; PG8_SCHED;
            PG8_LDB(B0, 1, 0); PG8_LDB(B1, 1, 1); PG8_SCHED; PG8_LDA(At, 1, 0); PG8_STAGE(PG8_SA(0, 1), a2 + hstepA, voffA);
            PG8_WAIT_V(8); PG8_WAIT_L(0); PG8_BAR; PG8_MMA(0, 0, At, B0); PG8_MMA(0, 1, At, B1); PG8_BAR; PG8_SCHED;
            PG8_LDA(At, 1, 1); PG8_STAGE(PG8_SB(1, 0), b3, voffB); PG8_STAGE(PG8_SB(1, 1), b3 + hstepB, voffB); PG8_STAGE(PG8_SA(1, 0), a3, voffA);
            PG8_WAIT_V(8); PG8_WAIT_L(0); PG8_BAR; PG8_MMA(1, 0, At, B0); PG8_MMA(1, 1, At, B1); PG8_BAR; PG8_SCHED;
        }
        if (wr == 0) PG8_BAR;
        E(acc, cur, wr, wc, fr, fq);
        if (!has_next) break;
#pragma unroll
        for (int a = 0; a < 2; ++a)
#pragma unroll
            for (int b = 0; b < 2; ++b)
#pragma unroll
                for (int m = 0; m < 4; ++m)
#pragma unroll
                    for (int n = 0; n < 2; ++n) acc[a][b][m][n] = (f32x4){0.f, 0.f, 0.f, 0.f};
        cur = nxt; cA = nA; cB = nB; ++ui;
        if (wr == 1) PG8_BAR;
    }
    PG8_WAIT_V(0);
    PG8_BAR;
#undef PG8_KOA
#undef PG8_SA
#undef PG8_SB
#undef PG8_STAGE
#undef PG8_LDA
#undef PG8_LDB
#undef PG8_MMA
#undef PG8_WAIT_V
#undef PG8_WAIT_L
#undef PG8_BAR
#undef PG8_SCHED
}

typedef const f32x4 (&AccRef)[2][2][4][2];
#define EPI_ROWS const int row0 = u.pm * BM + wr * 64 + fr
#define EPI_FOR_AM _Pragma("unroll") for (int ai = 0; ai < 2; ++ai) _Pragma("unroll") for (int m = 0; m < 4; ++m)
#define EPI_ROWSCALE(arr, ptr) float arr[2][4]; EPI_FOR_AM arr[ai][m] = (ptr)[row0 + ai * HALF + m * 16]

struct EpiPlain {
    bf16_t* O; int ldc;
    __device__ __forceinline__ void operator()(AccRef acc, const Unit& u, int wr, int wc, int fr, int fq) const {
        EPI_ROWS; const int col0 = u.pn * BM + wc * 32 + 8 * fq;
        EPI_FOR_AM { bf16_t* rp = O + (size_t)(row0 + ai * HALF + m * 16) * ldc + col0;
#pragma unroll
            for (int bj = 0; bj < 2; ++bj) *(u32x4*)(rp + bj * HALF) = pack8(acc[ai][bj][m][0], acc[ai][bj][m][1]); }
    }
};
struct EpiSwiGLU {
    bf16_t* O; const float* rstd;
    __device__ __forceinline__ void operator()(AccRef acc, const Unit& u, int wr, int wc, int fr, int fq) const {
        EPI_ROWS; const int col0 = u.pn * HALF + wc * 32 + 8 * fq;
        EPI_ROWSCALE(rsv, rstd);
        EPI_FOR_AM { f32x4 a, b; const float rs = rsv[ai][m];
#pragma unroll
            for (int j = 0; j < 4; ++j) { a[j] = fsilu(acc[ai][0][m][0][j] * rs) * (acc[ai][1][m][0][j] * rs); b[j] = fsilu(acc[ai][0][m][1][j] * rs) * (acc[ai][1][m][1][j] * rs); }
            *(u32x4*)(O + (size_t)(row0 + ai * HALF + m * 16) * DFF + col0) = pack8(a, b); }
    }
};
struct EpiSsq {
    bf16_t* O; float* ssq;
    __device__ __forceinline__ void operator()(AccRef acc, const Unit& u, int wr, int wc, int fr, int fq) const {
        EPI_ROWS; const int col0 = u.pn * BM + wc * 32 + 8 * fq;
        EPI_FOR_AM { const int row = row0 + ai * HALF + m * 16; bf16_t* rp = O + (size_t)row * DM + col0; float s = 0.f;
#pragma unroll
            for (int bj = 0; bj < 2; ++bj) { const f32x4 v0 = acc[ai][bj][m][0], v1 = acc[ai][bj][m][1];
                s += (v0[0] * v0[0] + v0[1] * v0[1]) + (v0[2] * v0[2] + v0[3] * v0[3]) + (v1[0] * v1[0] + v1[1] * v1[1]) + (v1[2] * v1[2] + v1[3] * v1[3]);
                *(u32x4*)(rp + bj * HALF) = pack8(v0, v1); }
            s += __shfl_xor(s, 16); s += __shfl_xor(s, 32);
            if (fq == 0) ssq[(size_t)row * 32 + u.pn * 4 + wc] = s; }
    }
};
struct EpiWin {
    bf16_t* Zlo; bf16_t* Cqkv; bf16_t* Zg; float* ssqc; const float* rstd;
    template <int MODE  >
    __device__ __forceinline__ void body(AccRef acc, const Unit& u, int wr, int wc, int fr, int fq, bf16_t* base, const int ldc, const int pnl) const {
        EPI_ROWS; const int col0 = pnl * BM + wc * 32 + 8 * fq;
        EPI_ROWSCALE(rsv, rstd);
        EPI_FOR_AM { const int row = row0 + ai * HALF + m * 16; const float rs = rsv[ai][m]; bf16_t* rp = base + (size_t)row * ldc + col0; float sq = 0.f;
#pragma unroll
            for (int bj = 0; bj < 2; ++bj) { f32x4 v0 = acc[ai][bj][m][0] * rs, v1 = acc[ai][bj][m][1] * rs;
                if (MODE == 2) {
#pragma unroll
                    for (int j = 0; j < 4; ++j) { v0[j] = fsigmoid(v0[j]); v1[j] = fsigmoid(v1[j]); } }
                if (MODE == 1) sq += (v0[0] * v0[0] + v0[1] * v0[1]) + (v0[2] * v0[2] + v0[3] * v0[3]) + (v1[0] * v1[0] + v1[1] * v1[1]) + (v1[2] * v1[2] + v1[3] * v1[3]);
                *(u32x4*)(rp + bj * HALF) = pack8(v0, v1); }
            if (MODE == 1) { sq += __shfl_xor(sq, 16); sq += __shfl_xor(sq, 32); if (fq == 0) ssqc[(size_t)row * 16 + pnl * 4 + wc] = sq; } }
    }
    __device__ __forceinline__ void operator()(AccRef acc, const Unit& u, int wr, int wc, int fr, int fq) const {
        if (u.pn >= 8) body<2>(acc, u, wr, wc, fr, fq, Zg, 4096, u.pn - 8);
        else if (u.pn >= 4) body<1>(acc, u, wr, wc, fr, fq, Cqkv, 1024, u.pn - 4);
        else body<0>(acc, u, wr, wc, fr, fq, Zlo, 2048, u.pn);
    }
};
struct EpiQ {
    bf16_t* Q; const float* cs; const float* sn; const float* rq;
    __device__ __forceinline__ void operator()(AccRef acc, const Unit& u, int wr, int wc, int fr, int fq) const {
        EPI_ROWS;
        EPI_ROWSCALE(rqv, rq);
        if (u.pn < 8) {
            EPI_FOR_AM { const float qs = QSCALE * rqv[ai][m]; bf16_t* rp = Q + (size_t)(row0 + ai * HALF + m * 16) * QW + wc * 32 + 8 * fq;
#pragma unroll
                for (int bj = 0; bj < 2; ++bj) *(u32x4*)(rp + (2 * u.pn + bj) * 192) = pack8(acc[ai][bj][m][0] * qs, acc[ai][bj][m][1] * qs); }
        } else {
            const int head = 4 * (u.pn - 8) + wc;
#pragma unroll
            for (int am = 0; am < 4; ++am) { const int ai = am >> 1;
                f32x4 cv[2][2], sv[2][2];
#pragma unroll
                for (int mm = 0; mm < 2; ++mm) { const int pos = NMETA + ((row0 + ai * HALF + (2 * (am & 1) + mm) * 16) & (SEQ - 1));
                    cv[mm][0] = *(const f32x4*)(cs + pos * 32 + 8 * fq); cv[mm][1] = *(const f32x4*)(cs + pos * 32 + 8 * fq + 4);
                    sv[mm][0] = *(const f32x4*)(sn + pos * 32 + 8 * fq); sv[mm][1] = *(const f32x4*)(sn + pos * 32 + 8 * fq + 4); }
#pragma unroll
                for (int mm = 0; mm < 2; ++mm) { const int m = 2 * (am & 1) + mm; const int row = row0 + ai * HALF + m * 16; const float qs = QSCALE * rqv[ai][m];
                const f32x4 c0 = cv[mm][0], c1 = cv[mm][1], s0 = sv[mm][0], s1 = sv[mm][1];
                const f32x4 x10 = acc[ai][0][m][0], x11 = acc[ai][0][m][1], x20 = acc[ai][1][m][0], x21 = acc[ai][1][m][1];
                const f32x4 o10 = (x10 * c0 - x20 * s0) * qs, o11 = (x11 * c1 - x21 * s1) * qs;
                const f32x4 o20 = (x20 * c0 + x10 * s0) * qs, o21 = (x21 * c1 + x11 * s1) * qs;
                bf16_t* rp = Q + (size_t)row * QW + head * 192 + 128 + 8 * fq;
                *(u32x4*)(rp) = pack8(o10, o11); *(u32x4*)(rp + 32) = pack8(o20, o21); } }
        }
    }
};
struct EpiKn {
    bf16_t* Kn; const float* rk;
    __device__ __forceinline__ void operator()(AccRef acc, const Unit& u, int wr, int wc, int fr, int fq) const {
        EPI_ROWS; const int col0 = u.pn * BM + wc * 32 + 8 * fq;
        EPI_ROWSCALE(rkv, rk);
        EPI_FOR_AM { const int row = row0 + ai * HALF + m * 16; const size_t kr = (size_t)(row >> 12) * LP + NMETA + (row & (SEQ - 1)); bf16_t* rp = Kn + kr * DM + col0;
#pragma unroll
            for (int bj = 0; bj < 2; ++bj) *(u32x4*)(rp + bj * HALF) = pack8(acc[ai][bj][m][0] * rkv[ai][m], acc[ai][bj][m][1] * rkv[ai][m]); }
    }
};
struct EpiVt {
    bf16_t* Vt; const float* rk;
    __device__ __forceinline__ void operator()(AccRef acc, const Unit& u, int wr, int wc, int fr, int fq) const {
        EPI_ROWS; const int col0 = u.pn * BM + wc * 32 + 8 * fq;
        f32x4 rv[2][2];
#pragma unroll
        for (int bj = 0; bj < 2; ++bj) { rv[bj][0] = *(const f32x4*)(rk + col0 + bj * HALF); rv[bj][1] = *(const f32x4*)(rk + col0 + bj * HALF + 4); }
        EPI_FOR_AM { const int rp_ = row0 + ai * HALF + m * 16;
#pragma unroll
            for (int bj = 0; bj < 2; ++bj) { const int c = col0 + bj * HALF; const int b = c >> 12, s = c & (SEQ - 1);
                *(u32x4*)(Vt + vt_idx(b, rp_, NMETA + s)) = pack8(acc[ai][bj][m][0] * rv[bj][0], acc[ai][bj][m][1] * rv[bj][1]); } }
    }
};
struct EpiGate1 {
    bf16_t* T; const bf16_t* Zg;
    __device__ __forceinline__ void operator()(AccRef acc, const Unit& u, int wr, int wc, int fr, int fq) const {
        EPI_ROWS; const int col0 = u.pn * BM + wc * 32 + 8 * fq;
#pragma unroll
        for (int ai = 0; ai < 2; ++ai) {
            u32x4 gv[4][2];
#pragma unroll
            for (int m = 0; m < 4; ++m)
#pragma unroll
                for (int bj = 0; bj < 2; ++bj) gv[m][bj] = *(const u32x4*)(Zg + (size_t)(row0 + ai * HALF + m * 16) * 4096 + col0 + bj * HALF);
#pragma unroll
            for (int m = 0; m < 4; ++m) { const int row = row0 + ai * HALF + m * 16;
#pragma unroll
                for (int bj = 0; bj < 2; ++bj) { float gf[8]; unpack8(gv[m][bj], gf);
                    f32x4 v0 = acc[ai][bj][m][0], v1 = acc[ai][bj][m][1];
#pragma unroll
                    for (int j = 0; j < 4; ++j) { v0[j] *= gf[j]; v1[j] *= gf[4 + j]; }
                    *(u32x4*)(T + (size_t)row * DM + col0 + bj * HALF) = pack8(v0, v1); } } }
    }
};
struct EpiGate2 {
    bf16_t* Y; const bf16_t* T; const bf16_t* Zg;
    __device__ __forceinline__ void operator()(AccRef acc, const Unit& u, int wr, int wc, int fr, int fq) const {
        EPI_ROWS; const int col0 = u.pn * BM + wc * 32 + 8 * fq;
#pragma unroll
        for (int ai = 0; ai < 2; ++ai) {
            u32x4 gv[4][2], tv[4][2];
#pragma unroll
            for (int m = 0; m < 4; ++m)
#pragma unroll
                for (int bj = 0; bj < 2; ++bj) { const int row = row0 + ai * HALF + m * 16;
                    gv[m][bj] = *(const u32x4*)(Zg + (size_t)row * 4096 + 2048 + col0 + bj * HALF); tv[m][bj] = *(const u32x4*)(T + (size_t)row * DM + col0 + bj * HALF); }
#pragma unroll
            for (int m = 0; m < 4; ++m) { const int row = row0 + ai * HALF + m * 16;
#pragma unroll
                for (int bj = 0; bj < 2; ++bj) { float gf[8]; unpack8(gv[m][bj], gf); float tf[8]; unpack8(tv[m][bj], tf);
                    f32x4 v0 = acc[ai][bj][m][0], v1 = acc[ai][bj][m][1];
#pragma unroll
                    for (int j = 0; j < 4; ++j) { v0[j] = tf[j] + v0[j] * gf[j]; v1[j] = tf[4 + j] + v1[j] * gf[4 + j]; }
                    *(u32x4*)(Y + (size_t)row * DM + col0 + bj * HALF) = pack8(v0, v1); } } }
    }
};
}

template <int RB, int CB>
__device__ __forceinline__ void skinny(const bf16_t* A, int lda, const bf16_t* W, int ldw, int cbrows, int K, f32x4 (&acc)[RB][CB], int lane) {
    constexpr int CH = (RB * CB >= 8) ? 64 : 128, NE = CH / 32;
    const int fr = lane & 15, fq = lane >> 4;
    const bf16_t* ap = A + (size_t)fr * lda + fq * (CH / 4);
    const bf16_t* wp = W + (size_t)fr * ldw + fq * (CH / 4);
#pragma unroll
    for (int rb = 0; rb < RB; ++rb)
#pragma unroll
        for (int cb = 0; cb < CB; ++cb) acc[rb][cb] = (f32x4){0.f, 0.f, 0.f, 0.f};
    bf16x8 a0[RB][NE], w0[CB][NE], a1[RB][NE], w1[CB][NE];
#define SK_LOAD(av, wv, kk) do { \
        _Pragma("unroll") for (int rb = 0; rb < RB; ++rb) _Pragma("unroll") for (int e = 0; e < NE; ++e) av[rb][e] = *(const bf16x8*)(ap + (size_t)rb * 16 * lda + (kk) + e * 8); \
        _Pragma("unroll") for (int cb = 0; cb < CB; ++cb) _Pragma("unroll") for (int e = 0; e < NE; ++e) wv[cb][e] = *(const bf16x8*)(wp + (size_t)cb * cbrows * ldw + (kk) + e * 8); } while (0)
#define SK_MMA(av, wv) do { \
        _Pragma("unroll") for (int e = 0; e < NE; ++e) _Pragma("unroll") for (int rb = 0; rb < RB; ++rb) _Pragma("unroll") for (int cb = 0; cb < CB; ++cb) \
            acc[rb][cb] = __builtin_amdgcn_mfma_f32_16x16x32_bf16(wv[cb][e], av[rb][e], acc[rb][cb], 0, 0, 0); } while (0)
    SK_LOAD(a0, w0, 0); SK_LOAD(a1, w1, CH);
    int k = 2 * CH;
#pragma clang loop unroll(disable)
    for (; k + CH < K; k += 2 * CH) {
        SK_MMA(a0, w0); SK_LOAD(a0, w0, k);
        SK_MMA(a1, w1); SK_LOAD(a1, w1, k + CH);
    }
    SK_MMA(a0, w0);
    if (k < K) SK_LOAD(a0, w0, k);
    SK_MMA(a1, w1);
    if (k < K) SK_MMA(a0, w0);
#undef SK_LOAD
#undef SK_MMA
}

__device__ __forceinline__ void transpose_item(const float* W, int ldw, int K, bf16_t* WT, int drow0, int scol0, int k0, LAS float* scr, int lane, const float* kg) {
    float tv[32];
    const float* wsrc = W + (size_t)(k0 + (lane >> 5)) * ldw + scol0 + (lane & 31);
#pragma unroll
    for (int i = 0; i < 32; ++i) tv[i] = wsrc[(size_t)(2 * i) * ldw];
    if (kg) {
#pragma unroll
        for (int i = 0; i < 32; ++i) tv[i] *= kg[k0 + 2 * i + (lane >> 5)]; }
#pragma unroll
    for (int i = 0; i < 32; ++i) scr[(2 * i + (lane >> 5)) * 33 + (lane & 31)] = tv[i];
    asm volatile("s_waitcnt lgkmcnt(0)" ::: "memory");
    const int c = lane & 7;
#pragma unroll
    for (int j = 0; j < 4; ++j) { const int n = (lane >> 3) + 8 * j; const LAS float* s = scr + (8 * c) * 33 + n;
        u32x4 o; o.x = pk2(s[0 * 33], s[1 * 33]); o.y = pk2(s[2 * 33], s[3 * 33]); o.z = pk2(s[4 * 33], s[5 * 33]); o.w = pk2(s[6 * 33], s[7 * 33]);
        *(u32x4*)(WT + (size_t)(drow0 + n) * K + k0 + 8 * c) = o; }
    asm volatile("s_waitcnt lgkmcnt(0)" ::: "memory");
}
__device__ __forceinline__ int srccol(int id, int r0) {
    switch (id) {
    case 0: { const int tile = r0 >> 8, r = r0 & 255; return (r < 128) ? 128 * tile + r : DFF + 128 * tile + (r - 128); }
    case 2: return r0 < 2048 ? r0 : r0 + 64;
    case 3: return 2048 + r0;
    case 4: { const int pn = r0 >> 8, r = r0 & 255, bj = r >> 7, rr = r & 127;
              return pn < 8 ? (2 * pn + bj) * 192 + rr : (4 * (pn - 8) + (rr >> 5)) * 192 + 128 + 32 * bj + (rr & 31); }
    case 5: return (r0 >> 7) * 256 + (r0 & 127);
    case 6: return (r0 >> 7) * 256 + 128 + (r0 & 127);
    default: return r0;
    }
}
__device__ __forceinline__ void conv_matrix(const float* W, int ldw, int K, int nrows, int id, bf16_t* WT, LAS float* scr, int lane, int& it, const int NGW, const float* kg = nullptr) {
    const int nblk = nrows / 32, nitems = (K / 64) * nblk;
    for (; it < nitems; it += NGW) { const int kb = it / nblk, nb = it % nblk; transpose_item(W, ldw, K, WT, 32 * nb, srccol(id, 32 * nb), 64 * kb, scr, lane, kg); }
    it -= nitems;
}

__device__ __forceinline__ void ld_row_f32(const float* p, int lane, f32x4 (&v)[8]) {
#pragma unroll
    for (int j = 0; j < 8; ++j) v[j] = *(const f32x4*)(p + 4 * lane + 256 * j);
}
__device__ __forceinline__ void ld_row_bf16(const bf16_t* p, int lane, f32x4 (&v)[8]) {
#pragma unroll
    for (int j = 0; j < 8; ++j) { const u32x2 w = *(const u32x2*)(p + 4 * lane + 256 * j); v[j] = (f32x4){bflo(w.x), bfhi(w.x), bflo(w.y), bfhi(w.y)}; }
}
__device__ __forceinline__ float row_ssq(const f32x4 (&v)[8]) {
    float s = 0.f;
#pragma unroll
    for (int j = 0; j < 8; ++j) s += (v[j][0] * v[j][0] + v[j][1] * v[j][1]) + (v[j][2] * v[j][2] + v[j][3] * v[j][3]);
    return wave_sum(s);
}
__device__ __forceinline__ void st_row_norm_bf16(bf16_t* dst, const f32x4 (&v)[8], float rstd, const float* gain, int lane) {
#pragma unroll
    for (int j = 0; j < 8; ++j) { const f32x4 g = *(const f32x4*)(gain + 4 * lane + 256 * j); const f32x4 o = v[j] * rstd * g;
        u32x2 w; w.x = pk2(o[0], o[1]); w.y = pk2(o[2], o[3]); *(u32x2*)(dst + 4 * lane + 256 * j) = w; }
}
__device__ __forceinline__ void st_row_bf16(bf16_t* dst, const f32x4 (&v)[8], int lane) {
#pragma unroll
    for (int j = 0; j < 8; ++j) { u32x2 w; w.x = pk2(v[j][0], v[j][1]); w.y = pk2(v[j][2], v[j][3]); *(u32x2*)(dst + 4 * lane + 256 * j) = w; }
}
__device__ __forceinline__ void st_row_scaled_bf16(bf16_t* dst, const f32x4 (&v)[8], float rstd, int lane) {
#pragma unroll
    for (int j = 0; j < 8; ++j) { const f32x4 o = v[j] * rstd; u32x2 w; w.x = pk2(o[0], o[1]); w.y = pk2(o[2], o[3]); *(u32x2*)(dst + 4 * lane + 256 * j) = w; }
}
__device__ __forceinline__ void add_normed(f32x4 (&v)[8], const f32x4 (&d)[8], float scale_rstd, const float* gain, int lane) {
#pragma unroll
    for (int j = 0; j < 8; ++j) { const f32x4 g = *(const f32x4*)(gain + 4 * lane + 256 * j); v[j] += d[j] * scale_rstd * g; }
}

constexpr int AT_KROW = 400, AT_KBUF = 64 * AT_KROW, AT_VROW = 144, AT_VBUF = 128 * AT_VROW, AT_NST = 3, AT_VOFF = AT_NST * AT_KBUF;
__device__ __forceinline__ int crow(int r, int hi) { return (r & 3) + 8 * (r >> 2) + 4 * hi; }
__device__ __forceinline__ void attn_unit(const int b, const int h, const int qb, const bf16_t* Q, bf16_t* Od, const int ldo, const int hso, const bf16_t* __restrict__ Kn, const bf16_t* __restrict__ Kpe, const bf16_t* __restrict__ Vt, LAS unsigned char* lds) {
    const int tid = threadIdx.x, lane = tid & 63, r32 = lane & 31, hi = lane >> 5; const int wid = __builtin_amdgcn_readfirstlane(tid >> 6);
    const int qrow = b * SEQ + qb * 256 + wid * 32 + r32;
    const int qpos0 = NMETA + qb * 256 + wid * 32, qpos = qpos0 + r32;
    bf16x8 qf[12];
#pragma unroll
    for (int d0 = 0; d0 < 12; ++d0) qf[d0] = *(const bf16x8*)(Q + (size_t)qrow * QW + h * 192 + d0 * 16 + hi * 8);
#pragma unroll
    for (int d0 = 0; d0 < 12; ++d0) asm volatile("" : "+v"(qf[d0]));
    f32x16 o[4];
#pragma unroll
    for (int i = 0; i < 4; ++i)
#pragma unroll
        for (int r = 0; r < 16; ++r) o[i][r] = 0.f;
    float mrun = -1e30f, lrun = 0.f;
    const int NT = 4 * qb + 5;
    const int kr0 = tid >> 4, kc0 = tid & 15;
    const int pr = tid >> 3, pc = tid & 7;
    const int vr0 = tid >> 3, vc0 = tid & 7;
    const int vso = (vc0 >> 1) * 32 + (vc0 & 1) * 8;
    const unsigned kno = (unsigned)((b * LP + kr0) * DM + h * 128 + kc0 * 8);
    const unsigned kpo = (unsigned)((b * LP + pr) * 64 + pc * 8);
    const unsigned vto = (unsigned)((((b * NH + h) * 65) * 128 + vr0) * 64 + vc0 * 8);
    u32x4 kreg[2], preg, vreg[2];
    f32x16 s0, s1;
#define AT_LOAD(t) do { kreg[0] = *(const u32x4*)(Kn + (kno + (unsigned)(64 * (t)) * DM)); kreg[1] = *(const u32x4*)(Kn + (kno + (unsigned)(64 * (t) + 32) * DM)); \
        preg = *(const u32x4*)(Kpe + (kpo + (unsigned)(64 * (t)) * 64)); vreg[0] = *(const u32x4*)(Vt + (vto + (unsigned)(8192 * (t)))); vreg[1] = *(const u32x4*)(Vt + (vto + (unsigned)(4096 + 8192 * (t)))); } while (0)
#define AT_STORE(stg) do { LAS unsigned char* kb_ = lds + (stg) * AT_KBUF; LAS unsigned char* vb_ = lds + AT_VOFF + (stg) * AT_VBUF; \
        *(LAS u32x4*)(kb_ + kr0 * AT_KROW + kc0 * 16) = kreg[0]; *(LAS u32x4*)(kb_ + (kr0 + 32) * AT_KROW + kc0 * 16) = kreg[1]; \
        *(LAS u32x4*)(kb_ + pr * AT_KROW + 256 + pc * 16) = preg; \
        *(LAS u32x2*)(vb_ + vr0 * AT_VROW + vso) = (u32x2){vreg[0].x, vreg[0].y}; *(LAS u32x2*)(vb_ + vr0 * AT_VROW + vso + 16) = (u32x2){vreg[0].z, vreg[0].w}; \
        *(LAS u32x2*)(vb_ + (vr0 + 64) * AT_VROW + vso) = (u32x2){vreg[1].x, vreg[1].y}; *(LAS u32x2*)(vb_ + (vr0 + 64) * AT_VROW + vso + 16) = (u32x2){vreg[1].z, vreg[1].w}; } while (0)
#define AT_QK(stg, tt) do { \
        _Pragma("unroll") for (int r = 0; r < 16; ++r) { s0[r] = 0.f; s1[r] = 0.f; } \
        const LAS unsigned char* kb = lds + (stg) * AT_KBUF + r32 * AT_KROW + hi * 16; \
        _Pragma("unroll") for (int d0 = 0; d0 < 12; ++d0) { \
            const bf16x8 a0 = *(const LAS bf16x8*)(kb + d0 * 32), a1 = *(const LAS bf16x8*)(kb + 32 * AT_KROW + d0 * 32); \
            s0 = __builtin_amdgcn_mfma_f32_32x32x16_bf16(a0, qf[d0], s0, 0, 0, 0); \
            s1 = __builtin_amdgcn_mfma_f32_32x32x16_bf16(a1, qf[d0], s1, 0, 0, 0); \
            } \
        if (64 * (tt) + 63 > qpos0) { \
            _Pragma("unroll") for (int r = 0; r < 16; ++r) { const int kv = 64 * (tt) + crow(r, hi); if (kv > qpos) s0[r] = -1e30f; if (kv + 32 > qpos) s1[r] = -1e30f; } } \
    } while (0)
#define AT_SPV(stg) do { \
        float mx = fmaxf(s0[0], s1[0]); \
        _Pragma("unroll") for (int r = 1; r < 16; ++r) mx = fmaxf(mx, fmaxf(s0[r], s1[r])); \
        { auto rr_ = __builtin_amdgcn_permlane32_swap(__float_as_uint(mx), __float_as_uint(mx), false, false); mx = fmaxf(__uint_as_float(rr_[0]), __uint_as_float(rr_[1])); } \
        const float mnew = fmaxf(mrun, mx), alpha = __builtin_amdgcn_exp2f(mrun - mnew); mrun = mnew; \
        float rs = 0.f; \
        _Pragma("unroll") for (int r = 0; r < 16; ++r) { s0[r] = __builtin_amdgcn_exp2f(s0[r] - mnew); s1[r] = __builtin_amdgcn_exp2f(s1[r] - mnew); rs += s0[r] + s1[r]; } \
        lrun = lrun * alpha + rs; \
        if (__builtin_amdgcn_ballot_w64(alpha != 1.0f) != 0ull) { \
            _Pragma("unroll") for (int i = 0; i < 4; ++i) _Pragma("unroll") for (int r = 0; r < 16; ++r) o[i][r] *= alpha; } \
        bf16x8 pf[4]; \
        { u32x4 w; \
          w.x = pk2(s0[0], s0[1]); w.y = pk2(s0[2], s0[3]); w.z = pk2(s0[4], s0[5]); w.w = pk2(s0[6], s0[7]); pf[0] = __builtin_bit_cast(bf16x8, w); \
          w.x = pk2(s0[8], s0[9]); w.y = pk2(s0[10], s0[11]); w.z = pk2(s0[12], s0[13]); w.w = pk2(s0[14], s0[15]); pf[1] = __builtin_bit_cast(bf16x8, w); \
          w.x = pk2(s1[0], s1[1]); w.y = pk2(s1[2], s1[3]); w.z = pk2(s1[4], s1[5]); w.w = pk2(s1[6], s1[7]); pf[2] = __builtin_bit_cast(bf16x8, w); \
          w.x = pk2(s1[8], s1[9]); w.y = pk2(s1[10], s1[11]); w.z = pk2(s1[12], s1[13]); w.w = pk2(s1[14], s1[15]); pf[3] = __builtin_bit_cast(bf16x8, w); } \
        const LAS unsigned char* vb = lds + AT_VOFF + (stg) * AT_VBUF + r32 * AT_VROW + hi * 16; \
        _Pragma("unroll") for (int db = 0; db < 4; ++db) _Pragma("unroll") for (int kb4 = 0; kb4 < 4; ++kb4) { \
            const u32x4 vv = *(const LAS u32x4*)(vb + db * 32 * AT_VROW + kb4 * 32); \
            o[db] = __builtin_amdgcn_mfma_f32_32x32x16_bf16(__builtin_bit_cast(bf16x8, vv), pf[kb4], o[db], 0, 0, 0); \
            } \
    } while (0)
    if (wid >= 4) __builtin_amdgcn_s_setprio(1);
    AT_LOAD(0); AT_STORE(0);
    __syncthreads();
    int st_prev = 2, st_cur = 0, st_next = 1;
    const int tlast = (qpos0 + 31) >> 6;
#define AT_ROT() do { st_prev = st_cur; st_cur = st_next; st_next = (st_next == AT_NST - 1) ? 0 : st_next + 1; } while (0)
#ifndef AT_PINGPONG
#define AT_PINGPONG 0
#endif
    if (!AT_PINGPONG || wid < 4) {
#pragma clang loop unroll(disable)
        for (int t = 0; t < NT + AT_PINGPONG; ++t) {
            if (t + 1 < NT) AT_LOAD(t + 1);
            if (t <= tlast) { AT_QK(st_cur, t); AT_SPV(st_cur); }
            if (t + 1 < NT) AT_STORE(st_next);
            __syncthreads();
            AT_ROT();
        }
    } else {
#pragma clang loop unroll(disable)
        for (int t = 0; t <= NT; ++t) {
            if (t >= 1 && t - 1 <= tlast) AT_SPV(st_prev);
            asm volatile("" ::: "memory");
            if (t + 1 < NT) AT_LOAD(t + 1);
            if (t <= tlast) AT_QK(st_cur, t);
            if (t + 1 < NT) AT_STORE(st_next);
            __syncthreads();
            AT_ROT();
        }
    }
#undef AT_ROT
#undef AT_LOAD
#undef AT_STORE
#undef AT_QK
#undef AT_SPV
    __builtin_amdgcn_s_setprio(0);
    const float l = lrun + __shfl_xor(lrun, 32), inv = 1.f / l;
    bf16_t* op = Od + (size_t)qrow * ldo + h * hso;
#pragma unroll
    for (int db = 0; db < 4; ++db)
#pragma unroll
        for (int k = 0; k < 2; ++k) { const int ga = 8 * k, gb = 8 * k + 4;
            const unsigned ax = pk2(o[db][ga] * inv, o[db][ga + 1] * inv), ay = pk2(o[db][ga + 2] * inv, o[db][ga + 3] * inv);
            const unsigned bx_ = pk2(o[db][gb] * inv, o[db][gb + 1] * inv), by_ = pk2(o[db][gb + 2] * inv, o[db][gb + 3] * inv);
            const auto rx = __builtin_amdgcn_permlane32_swap(ax, bx_, false, false); const auto ry = __builtin_amdgcn_permlane32_swap(ay, by_, false, false);
            const u32x4 v = {rx[0], ry[0], rx[1], ry[1]};
            *(u32x4*)(op + 32 * db + 16 * k + 8 * hi) = v; }
}

#define XB_TMO      128
#define XB_XCNT(j)  (256  + 64 * (j))
#define XB_XSUB(j)  (1280 + 64 * (j))
#define XB_XGEN(j)  (2304 + 64 * (j))
#define XB_TOP      3328
#define XB_TOPGEN   3392
#define XCD_BAR_WORDS 3456
#define XB_SPIN_CAP (1u << 22)
__device__ __forceinline__ unsigned xb_ld(unsigned* p)              { return __hip_atomic_load(p, __ATOMIC_RELAXED, __HIP_MEMORY_SCOPE_AGENT); }
__device__ __forceinline__ unsigned xb_add(unsigned* p, unsigned v) { return __hip_atomic_fetch_add(p, v, __ATOMIC_RELAXED, __HIP_MEMORY_SCOPE_AGENT); }
__device__ __forceinline__ unsigned xb_xcc_id() { return (unsigned)__builtin_amdgcn_s_getreg((3 << 11) | 20) & 0xFu; }
#define XB_SPIN(cond, bar) do { unsigned _sp = 0; while (cond) { __builtin_amdgcn_s_sleep(1); \
    if ((++_sp & 255u) == 0u) { if (xb_ld(&(bar)[XB_TMO])) break; if (_sp > XB_SPIN_CAP) { atomicAdd(&(bar)[XB_TMO], 1u); break; } } } } while (0)
struct XcdBarrier { unsigned* bar; unsigned x; volatile LAS unsigned* st; };
__device__ __forceinline__ XcdBarrier xcd_barrier_post(unsigned* bar, volatile LAS unsigned* st) {
    XcdBarrier b; b.bar = bar; b.x = xb_xcc_id(); b.st = st;
    if (threadIdx.x == 0) (void)xb_add(&bar[XB_XCNT(b.x)], 1u);
    return b;
}
__device__ __forceinline__ void xcd_barrier_complete(unsigned* bar, unsigned x, unsigned& nloc, unsigned& nx) {
    const unsigned G = gridDim.x * gridDim.y * gridDim.z;
    unsigned sum, cnt, mine, sp = 0u;
    for (;;) {
        sum = 0u; cnt = 0u; mine = 0u;
#pragma unroll
        for (unsigned j = 0; j < 16; ++j) { const unsigned c = xb_ld(&bar[XB_XCNT(j)]); sum += c; cnt += (c > 0u) ? 1u : 0u; mine = (j == x) ? c : mine; }
        if (sum == G) break;
        __builtin_amdgcn_s_sleep(1);
        if ((++sp & 255u) == 0u) { if (xb_ld(&bar[XB_TMO])) break; if (sp > XB_SPIN_CAP) { atomicAdd(&bar[XB_TMO], 1u); break; } }
    }
    nloc = mine > 0u ? mine : 1u; nx = cnt > 0u ? cnt : 1u;
}
__device__ __forceinline__ void xcd_barrier(const XcdBarrier& b) {
    asm volatile("s_waitcnt vmcnt(0)" ::: "memory");
    __syncthreads();
    if (threadIdx.x == 0) {
        unsigned* bar = b.bar;
        __builtin_amdgcn_s_waitcnt(0);
        unsigned nloc = b.st[0], nx = b.st[1];
        if (nloc == 0u) { xcd_barrier_complete(bar, b.x, nloc, nx); b.st[0] = nloc; b.st[1] = nx; }
        const unsigned old = xb_add(&bar[XB_XSUB(b.x)], 1u);
        const unsigned gen = old / nloc;
        if (old + 1u == (gen + 1u) * nloc) {
            __builtin_amdgcn_fence(__ATOMIC_RELEASE, "agent");
            asm volatile("s_waitcnt vmcnt(0)" ::: "memory");
            const unsigned og = xb_add(&bar[XB_TOP], 1u);
            const unsigned tg = og / nx;
            if (og + 1u == (tg + 1u) * nx) xb_add(&bar[XB_TOPGEN], 1u);
            else XB_SPIN(xb_ld(&bar[XB_TOPGEN]) == tg, bar);
            __builtin_amdgcn_fence(__ATOMIC_ACQUIRE, "agent");
            xb_add(&bar[XB_XGEN(b.x)], 1u);
            asm volatile("s_waitcnt vmcnt(0)" ::: "memory");
        } else {
            XB_SPIN(xb_ld(&bar[XB_XGEN(b.x)]) == gen, bar);
            __builtin_amdgcn_fence(__ATOMIC_ACQUIRE, "agent");
            asm volatile("s_waitcnt vmcnt(0)" ::: "memory");
        }
    }
    __syncthreads();
}

struct Args { const float* in[22]; float* out; unsigned char* ws; int ph_lo, ph_hi, coop, pad; };

__global__ void __launch_bounds__(512, 2) mk_fwd(Args args) {
    extern __shared__ __attribute__((aligned(16))) unsigned char lds_raw[];
    LAS unsigned char* lds = (LAS unsigned char*)lds_raw;
    const int tid = threadIdx.x, lane = tid & 63, wave = __builtin_amdgcn_readfirstlane(tid >> 6);
    const int G = gridDim.x, bx = blockIdx.x;
#define vcu ((G % 8 == 0) ? (bx % 8) * (G / 8) + bx / 8 : bx)
#define gw (wave * G + bx)
#define NGW (G * 8)
#define gt (bx * 512 + tid)
#define NGT (G * 512)
    unsigned char* ws = args.ws;
    const float* x = args.in[0]; const float* meta = args.in[1];
    float* out = args.out;
#define COS ((float*)(ws + WS_COS))
#define SIN ((float*)(ws + WS_SIN))
#define SSQ ((float*)(ws + WS_SSQ))
#define SSQC ((float*)(ws + WS_RSTD1))
#define RSTD1X ((float*)(ws + 128 * 1024))
#define RSTD2 ((float*)(ws + 256 * 1024))
#define RSTD3 ((float*)(ws + 320 * 1024))
#define RSTDQ ((float*)(ws + 384 * 1024))
#define RSTDKV ((float*)(ws + 448 * 1024))
#define A1M ((bf16_t*)(ws + WS_A1M))
#define ACT1M ((bf16_t*)(ws + WS_ACT1M))
#define D1MP ((float*)(ws + WS_D1MP))
#define A2M ((bf16_t*)(ws + WS_A2M))
#define ZLOM ((bf16_t*)(ws + WS_ZLOM))
#define KRM ((float*)(ws + WS_KRM))
#define CKVNM ((bf16_t*)(ws + WS_CKVNM))
#define KPE ((bf16_t*)(ws + WS_KPE))
#define WIN ((bf16_t*)(ws + WS_WIN))
#define WKR ((bf16_t*)(ws + WS_WKR))
#define PWS ((bf16_t*)(ws + WS_PWS))
#define WPO ((bf16_t*)(ws + WS_WPO))
#define WF ((bf16_t*)(ws + WS_WF))
#define WQB ((bf16_t*)(ws + WS_WQB))
#define WK ((bf16_t*)(ws + WS_WK))
#define WV ((bf16_t*)(ws + WS_WV))
#define WMO ((bf16_t*)(ws + WS_WMO))
#define WOUT ((bf16_t*)(ws + WS_WOUT))
#define WGU ((bf16_t*)(ws + WS_WGU))
#define WD ((bf16_t*)(ws + WS_WD))
#define DPOOL ((bf16_t*)(ws + WS_DPOOL))
#define CQKV ((bf16_t*)(ws + WS_CQN))
#define AB ((bf16_t*)(ws + WS_A))
#define ACT ((bf16_t*)(ws + WS_ACT))
#define D1 ((bf16_t*)(ws + WS_D1))
#define TB ((bf16_t*)(ws + WS_T))
#define ZLO ((bf16_t*)(ws + WS_ZLO))
#define KN ((bf16_t*)(ws + WS_KN))
#define VT ((bf16_t*)(ws + WS_VT))
#define QB ((bf16_t*)(ws + WS_Q))
#define YB ((bf16_t*)(ws + WS_Y))
#define MMB ((bf16_t*)(ws + WS_MM))
#define D2 ((bf16_t*)(ws + WS_D2))
#define ZG ((bf16_t*)out)
#define scr ((LAS float*)(lds + wave * 16384))

    const int lo = args.ph_lo, hi_ph = args.ph_hi;
    volatile LAS unsigned* bst = (volatile LAS unsigned*)(lds + 140000);
    if (tid < 2) bst[tid] = 0u;
    __syncthreads();
    XcdBarrier xbar; xbar.bar = (unsigned*)ws; xbar.x = 0; xbar.st = bst;
    if (args.coop) {
        if (bx == 0) { for (int i = tid; i < XCD_BAR_WORDS; i += 512) ((unsigned*)ws)[i] = 0u; }
        cg::this_grid().sync();
        xbar = xcd_barrier_post((unsigned*)ws, bst);
    }
#ifndef PHMASK
#define PHMASK 0x3fff
#endif
#define IN(k) (((PHMASK >> (k)) & 1) && lo <= (k) && (k) < hi_ph)
#define SEAM(k) do { if (args.coop && IN(k) && IN((k) + 1)) { xcd_barrier(xbar); if (DUP_SYNC) xcd_barrier(xbar); } } while (0)

    if (IN(0)) {
        int it = gw;
        conv_matrix(args.in[4], NGU, DM, NGU, 0, WGU, scr, lane, it, NGW, args.in[2]);
        conv_matrix(args.in[5], DM, DFF, DM, 1, WD, scr, lane, it, NGW);
        conv_matrix(args.in[8], 6208, DM, 6144, 2, WIN, scr, lane, it, NGW, args.in[6]);
        conv_matrix(args.in[8], 6208, DM, 64, 3, WKR, scr, lane, it, NGW, args.in[6]);
        conv_matrix(args.in[11], DM, 1024, DM, 1, WPO, scr, lane, it, NGW);
        conv_matrix(args.in[13], 3072, 512, 3072, 4, WQB, scr, lane, it, NGW, args.in[12]);
        conv_matrix(args.in[15], 4096, 512, 2048, 5, WK, scr, lane, it, NGW, args.in[14]);
        conv_matrix(args.in[15], 4096, 512, 2048, 6, WV, scr, lane, it, NGW, args.in[14]);
        conv_matrix(args.in[16], DM, DM, DM, 1, WMO, scr, lane, it, NGW);
        conv_matrix(args.in[17], DM, DM, DM, 1, WOUT, scr, lane, it, NGW);
        for (int i = gt; i < LP * 32; i += NGT) {
            const int pos = i >> 5, k = i & 31; double iv = 1.0;
            for (int q = 0; q < k; ++q) iv *= 0.7498942093324559;
            const float ang = (float)pos * (float)iv;
            const double xa = (double)ang; const double nq = __builtin_rint(xa * 0.6366197723675814);
            double r = __builtin_fma(-nq, 1.5707963109016418, xa); r = __builtin_fma(-nq, 1.5893254773528196e-08, r);
            const double r2 = r * r;
            double sp = 1.0 / 6227020800.0; sp = sp * r2 - 1.0 / 39916800.0; sp = sp * r2 + 1.0 / 362880.0; sp = sp * r2 - 1.0 / 5040.0; sp = sp * r2 + 1.0 / 120.0; sp = sp * r2 - 1.0 / 6.0; sp = sp * r2 + 1.0; sp *= r;
            double cp = -1.0 / 87178291200.0; cp = cp * r2 + 1.0 / 479001600.0; cp = cp * r2 - 1.0 / 3628800.0; cp = cp * r2 + 1.0 / 40320.0; cp = cp * r2 - 1.0 / 720.0; cp = cp * r2 + 1.0 / 24.0; cp = cp * r2 - 0.5; cp = cp * r2 + 1.0;
            const int qd = ((int)nq) & 3;
            const double sv = (qd == 0) ? sp : (qd == 1) ? cp : (qd == 2) ? -sp : -cp;
            const double cv = (qd == 0) ? cp : (qd == 1) ? -sp : (qd == 2) ? -cp : sp;
            COS[i] = (float)cv; SIN[i] = (float)sv;
        }
        for (int i = gt; i < 1024 * 256 / 2; i += NGT) { const int e = 2 * i, g = e >> 16, j = e & 255;
            const f32x2 w = *(const f32x2*)(args.in[9] + e); const f32x2 s = *(const f32x2*)(args.in[10] + g * 256 + j);
            *(unsigned*)(PWS + e) = pk2(w.x * s.x, w.y * s.y); }
        for (int m = gw; m < M + NMETA; m += NGW) {
            f32x4 v[8]; const bool ism = m >= M; ld_row_f32(ism ? meta + (size_t)(m - M) * DM : x + (size_t)m * DM, lane, v);
            const float rstd = rsqrtf(row_ssq(v) * (1.f / DM) + EPS);
            if (ism) st_row_scaled_bf16(A1M + (size_t)(m - M) * DM, v, rstd, lane);
            else { st_row_bf16(AB + (size_t)m * DM, v, lane); if (lane == 0) RSTD1X[m] = rstd; }
        }
    }
    SEAM(0);
    if (IN(1)) {
        pg8::Gemm g{AB, WGU, DM, DM, DM, 0, 30, 0, M / 256, NGU / 256};
        pg8::EpiSwiGLU E{ACT, RSTD1X};
        pg8::gemm_phase(lds, g, G, bx, E);
        if (DUP_P1) pg8::gemm_phase(lds, g, G, bx, E);
        for (int it = gw; it < DFF / 16; it += NGW) {
            const int c0 = 16 * it, wrow = 256 * (c0 >> 7) + (c0 & 127);
            f32x4 acc[1][2]; skinny<1, 2>(A1M, DM, WGU + (size_t)wrow * DM, DM, 128, DM, acc, lane);
            const int fr = lane & 15, fq = lane >> 4; u32x2 w;
            w.x = pk2(fsilu(acc[0][0][0]) * acc[0][1][0], fsilu(acc[0][0][1]) * acc[0][1][1]); w.y = pk2(fsilu(acc[0][0][2]) * acc[0][1][2], fsilu(acc[0][0][3]) * acc[0][1][3]);
            *(u32x2*)(ACT1M + (size_t)fr * DFF + c0 + 4 * fq) = w;
        }
    }
    SEAM(1);
    if (IN(2)) {
        pg8::Gemm g{ACT, WD, DFF, DFF, DFF, 0, 30, 0, M / 256, DM / 256};
        pg8::EpiSsq E{D1, SSQ};
        pg8::gemm_phase(lds, g, G, bx, E);
        for (int it = gw; it < 512; it += NGW) {
            const int cb = it & 127, ks = it >> 7;
            f32x4 acc[1][1]; skinny<1, 1>(ACT1M + ks * 1408, DFF, WD + (size_t)(16 * cb) * DFF + ks * 1408, DFF, 16, 1408, acc, lane);
            const int fr = lane & 15, fq = lane >> 4;
            *(f32x4*)(D1MP + (size_t)ks * 16 * DM + (size_t)fr * DM + 16 * cb + 4 * fq) = acc[0][0];
        }
    }
    SEAM(2);
    if (IN(3)) {
        for (int it = gw; it < 2048; it += NGW) {
            const int n0 = (it >> 4) * 16, g = (it >> 2) & 3, cq = it & 3, fr = lane & 15, fq = lane >> 4;
            f32x4 acc[1][4]; skinny<1, 4>(WPO + (size_t)n0 * 1024 + 256 * g, 1024, PWS + (size_t)(256 * g + 64 * cq) * 256, 256, 16, 256, acc, lane);
#pragma unroll
            for (int cb = 0; cb < 4; ++cb) { u32x2 w; w.x = pk2(acc[0][cb][0], acc[0][cb][1]); w.y = pk2(acc[0][cb][2], acc[0][cb][3]);
                *(u32x2*)(WF + (size_t)(n0 + fr) * 1024 + 256 * g + 64 * cq + 16 * cb + 4 * fq) = w; }
        }
#ifndef NO_P3ROWS
        for (int m = gw; m < M + NMETA; m += NGW) {
            f32x4 v[8], d[8]; const bool ism = m >= M; float rstd1;
            if (!ism) {
                ld_row_bf16(AB + (size_t)m * DM, lane, v); ld_row_bf16(D1 + (size_t)m * DM, lane, d);
                const float ss = wave_sum(lane < 32 ? SSQ[(size_t)m * 32 + lane] : 0.f);
                rstd1 = rsqrtf(ss * (1.f / DM) + EPS);
            } else {
                const int mm = m - M; ld_row_f32(meta + (size_t)mm * DM, lane, v);
                ld_row_f32(D1MP + (size_t)mm * DM, lane, d);
                for (int ks = 1; ks < 4; ++ks) {
#pragma unroll
                    for (int j = 0; j < 8; ++j) d[j] += *(const f32x4*)(D1MP + (size_t)ks * 16 * DM + (size_t)mm * DM + 4 * lane + 256 * j);
                    asm volatile("" ::: "memory"); }
                rstd1 = rsqrtf(row_ssq(d) * (1.f / DM) + EPS);
            }
            add_normed(v, d, 0.5f * rstd1, args.in[3], lane);
            if (!ism) st_row_bf16(D1 + (size_t)m * DM, v, lane);
            const float rstd = rsqrtf(row_ssq(v) * (1.f / DM) + EPS);
            if (ism) st_row_scaled_bf16(A2M + (size_t)(m - M) * DM, v, rstd, lane);
            else if (lane == 0) RSTD2[m] = rstd;
        }
#endif
    }
    SEAM(3);
    if (IN(4)) {
        pg8::Gemm g{D1, WIN, DM, DM, DM, 0, 30, 0, M / 256, 6144 / 256};
        pg8::EpiWin E{ZLO, CQKV, ZG, SSQC, RSTD2};
        pg8::gemm_phase(lds, g, G, bx, E);
        for (int it = gw; it < 100; it += NGW) {
            const bf16_t* w; int ocol; bool kr = false;
            if (it < 64) { w = WIN + (size_t)(16 * it) * DM; ocol = 16 * it; }
            else if (it < 96) { w = WIN + (size_t)(1536 + 16 * (it - 64)) * DM; ocol = 1536 + 16 * (it - 64); }
            else { w = WKR + (size_t)(16 * (it - 96)) * DM; ocol = 16 * (it - 96); kr = true; }
            f32x4 acc[1][1]; skinny<1, 1>(A2M, DM, w, DM, 16, DM, acc, lane);
            const int fr = lane & 15, fq = lane >> 4;
            if (kr) *(f32x4*)(KRM + fr * 64 + ocol + 4 * fq) = acc[0][0];
            else { u32x2 o; o.x = pk2(acc[0][0][0], acc[0][0][1]); o.y = pk2(acc[0][0][2], acc[0][0][3]); *(u32x2*)(ZLOM + (size_t)fr * DM + ocol + 4 * fq) = o; }
        }
    }
    SEAM(4);
    if (IN(5)) {
        for (int it = gw; it < M / 32; it += NGW) {
            f32x4 acc[2][4]; skinny<2, 4>(D1 + (size_t)(32 * it) * DM, DM, WKR, DM, 16, DM, acc, lane);
            const int fr = lane & 15, fq = lane >> 4;
#pragma unroll
            for (int rb = 0; rb < 2; ++rb) { const int row = 32 * it + 16 * rb + fr; const int pos = NMETA + (row & (SEQ - 1)); const size_t kr = (size_t)(row >> 12) * LP + pos; const float rs = RSTD2[row];
#pragma unroll
                for (int cb = 0; cb < 2; ++cb) { const int dd = 16 * cb + 4 * fq; const f32x4 c = *(const f32x4*)(COS + pos * 32 + dd), s = *(const f32x4*)(SIN + pos * 32 + dd);
                    const f32x4 x1 = acc[rb][cb] * rs, x2 = acc[rb][cb + 2] * rs; const f32x4 o1 = x1 * c - x2 * s, o2 = x2 * c + x1 * s;
                    u32x2 w; w.x = pk2(o1[0], o1[1]); w.y = pk2(o1[2], o1[3]); *(u32x2*)(KPE + kr * 64 + dd) = w;
                    w.x = pk2(o2[0], o2[1]); w.y = pk2(o2[2], o2[3]); *(u32x2*)(KPE + kr * 64 + 32 + dd) = w; } }
        }
        if (gw == NGW - 1) {
            for (int p = 0; p < NMETA; ++p) if (lane < 32) { const float x1 = KRM[p * 64 + lane], x2 = KRM[p * 64 + 32 + lane]; const float c = COS[p * 32 + lane], s = SIN[p * 32 + lane];
                const float o1 = x1 * c - x2 * s, o2 = x2 * c + x1 * s;
                for (int b = 0; b < NB; ++b) { KPE[((size_t)b * LP + p) * 64 + lane] = (bf16_t)(pk2(o1, 0.f) & 0xffff); KPE[((size_t)b * LP + p) * 64 + 32 + lane] = (bf16_t)(pk2(o2, 0.f) & 0xffff); } }
        }
        for (int m = gt; m < M; m += NGT) { const f32x4* p = (const f32x4*)(SSQC + (size_t)m * 16); const f32x4 a = p[0], b2 = p[1], c = p[2], d = p[3];
            RSTDQ[m] = rsqrtf(((a[0] + a[1]) + (a[2] + a[3]) + (b2[0] + b2[1]) + (b2[2] + b2[3])) * (1.f / 512) + EPS);
            RSTDKV[m] = rsqrtf(((c[0] + c[1]) + (c[2] + c[3]) + (d[0] + d[1]) + (d[2] + d[3])) * (1.f / 512) + EPS); }
        for (int mm = gw; mm < NMETA; mm += NGW) {
            float f[8]; unpack8(*(const u32x4*)(ZLOM + (size_t)mm * DM + 1536 + 8 * lane), f); float ss = 0.f;
#pragma unroll
            for (int j = 0; j < 8; ++j) ss += f[j] * f[j];
            const float rstd = rsqrtf(wave_sum(ss) * (1.f / 512) + EPS);
            u32x4 w; w.x = pk2(f[0] * rstd, f[1] * rstd); w.y = pk2(f[2] * rstd, f[3] * rstd); w.z = pk2(f[4] * rstd, f[5] * rstd); w.w = pk2(f[6] * rstd, f[7] * rstd);
            *(u32x4*)(CKVNM + (size_t)mm * 512 + 8 * lane) = w;
        }
        for (int it = gw; it < (M / 16) * 2; it += NGW) {
            const int rc = it >> 1, hf = it & 1, row0 = rc * 16, b = row0 >> 12, s0 = row0 & (SEQ - 1), c0 = hf * 512 + 8 * lane;
            const int w = 2 << (c0 >> 8); const float invw = 1.f / (float)w;
            float sum[8];
#pragma unroll
            for (int j = 0; j < 8; ++j) sum[j] = 0.f;
#define POOL_LD(s_, f_) do { const int ss_ = (s_); const bf16_t* p_ = ss_ >= 0 ? ZLO + ((size_t)b * SEQ + ss_) * DM + c0 : ZLOM + (size_t)(NMETA + ss_) * DM + c0; unpack8(*(const u32x4*)p_, f_); } while (0)
#define POOL_PTR(s_) ((s_) >= 0 ? ZLO + ((size_t)b * SEQ + (s_)) * DM + c0 : ZLOM + (size_t)(NMETA + (s_)) * DM + c0)
            u32x4 wu[15], cu[16], ol[16];
#pragma unroll
            for (int j = 1; j < 16; ++j) { wu[j - 1] = (u32x4){0u, 0u, 0u, 0u}; if (j < w) wu[j - 1] = *(const u32x4*)POOL_PTR(s0 - j); }
#pragma unroll
            for (int i = 0; i < 16; ++i) { cu[i] = *(const u32x4*)POOL_PTR(s0 + i); ol[i] = *(const u32x4*)POOL_PTR(s0 + i - w + 1); }
#pragma unroll
            for (int j = 0; j < 15; ++j) { float f[8]; unpack8(wu[j], f);
#pragma unroll
                for (int e = 0; e < 8; ++e) sum[e] += f[e]; }
#pragma unroll
            for (int i = 0; i < 16; ++i) { float cur[8], old[8]; unpack8(cu[i], cur); unpack8(ol[i], old);
                float o[8];
#pragma unroll
                for (int e = 0; e < 8; ++e) { sum[e] += cur[e]; o[e] = sum[e] * invw - cur[e]; sum[e] -= old[e]; }
                u32x4 wv; wv.x = pk2(o[0], o[1]); wv.y = pk2(o[2], o[3]); wv.z = pk2(o[4], o[5]); wv.w = pk2(o[6], o[7]);
                *(u32x4*)(DPOOL + (size_t)(row0 + i) * 1024 + c0) = wv; }
#undef POOL_PTR
#undef POOL_LD
        }
    }
    SEAM(5);
    if (IN(6)) {
        { const u32x4 z = {0u, 0u, 0u, 0u};
          for (int i = gt; i < NB * 48 * 256; i += NGT) { const int b = i / (48 * 256), r = (i / 256) % 48, c = i % 256; *(u32x4*)(KN + ((size_t)b * LP + 4112 + r) * DM + c * 8) = z; }
          for (int i = gt; i < NB * DM * 6; i += NGT) { const int rr = i / 6, c = i % 6; *(u32x4*)(VT + vt_idx(rr >> 11, rr & 2047, 4112 + c * 8)) = z; }
          for (int i = gt; i < NB * 48 * 8; i += NGT) { const int b = i / (48 * 8), r = (i / 8) % 48, c = i % 8; *(u32x4*)(KPE + ((size_t)b * LP + 4112 + r) * 64 + c * 8) = z; } }
        if (bx & 1) {
            { pg8::Gemm g{DPOOL, WF, 1024, 1024, 1024, 0, 30, 0, M / 256, DM / 256}; pg8::EpiGate1 E{TB, ZG}; pg8::gemm_phase(lds, g, G, bx, E); }
            { pg8::Gemm g{WV, CQKV + 512, 512, 1024, 512, 0, 30, 0, DM / 256, M / 256}; pg8::EpiVt E{VT, RSTDKV}; pg8::gemm_phase(lds, g, G, bx, E); }
            { pg8::Gemm g{CQKV + 512, WK, 1024, 512, 512, 0, 30, 0, M / 256, DM / 256}; pg8::EpiKn E{KN, RSTDKV}; pg8::gemm_phase(lds, g, G, bx, E); }
            { pg8::Gemm g{CQKV, WQB, 1024, 512, 512, 0, 30, 0, M / 256, 3072 / 256}; pg8::EpiQ E{QB, COS, SIN, RSTDQ}; pg8::gemm_phase(lds, g, G, bx, E); }
        } else {
            { pg8::Gemm g{CQKV, WQB, 1024, 512, 512, 0, 30, 0, M / 256, 3072 / 256}; pg8::EpiQ E{QB, COS, SIN, RSTDQ}; pg8::gemm_phase(lds, g, G, bx, E); }
            { pg8::Gemm g{CQKV + 512, WK, 1024, 512, 512, 0, 30, 0, M / 256, DM / 256}; pg8::EpiKn E{KN, RSTDKV}; pg8::gemm_phase(lds, g, G, bx, E); }
            { pg8::Gemm g{WV, CQKV + 512, 512, 1024, 512, 0, 30, 0, DM / 256, M / 256}; pg8::EpiVt E{VT, RSTDKV}; pg8::gemm_phase(lds, g, G, bx, E); }
            { pg8::Gemm g{DPOOL, WF, 1024, 1024, 1024, 0, 30, 0, M / 256, DM / 256}; pg8::EpiGate1 E{TB, ZG}; pg8::gemm_phase(lds, g, G, bx, E); }
        }
        for (int it = gw; it < 256; it += NGW) {
            const int fr = lane & 15, fq = lane >> 4; f32x4 acc[1][1];
            if (it < 128) { skinny<1, 1>(CKVNM, 512, WK + (size_t)(16 * it) * 512, 512, 16, 512, acc, lane);
                u32x2 w; w.x = pk2(acc[0][0][0], acc[0][0][1]); w.y = pk2(acc[0][0][2], acc[0][0][3]);
                for (int b = 0; b < NB; ++b) *(u32x2*)(KN + ((size_t)b * LP + fr) * DM + 16 * it + 4 * fq) = w;
            } else { const int i2 = it - 128; skinny<1, 1>(CKVNM, 512, WV + (size_t)(16 * i2) * 512, 512, 16, 512, acc, lane);
                for (int b = 0; b < NB; ++b)
#pragma unroll
                    for (int j = 0; j < 4; ++j) VT[vt_idx(b, 16 * i2 + 4 * fq + j, fr)] = (bf16_t)(pk2(acc[0][0][j], 0.f) & 0xffff); }
        }
    }
    SEAM(6);
    if (IN(7)) {
#ifndef NO_ATTN
        for (int v = vcu; v < 256; v += G) {
            const int bh = v >> 2, j = v & 3, b = bh >> 4, h = bh & 15;
#if DUP_ATTN
            attn_unit(b, h, 15 - j, QB, DPOOL, DM, 128, KN, KPE, VT, lds);
            attn_unit(b, h, 8 + j, QB, DPOOL, DM, 128, KN, KPE, VT, lds);
            attn_unit(b, h, 7 - j, QB, DPOOL, DM, 128, KN, KPE, VT, lds);
            attn_unit(b, h, j, QB, DPOOL, DM, 128, KN, KPE, VT, lds);
#endif
#pragma clang loop unroll(disable)
            for (int ui = 0; ui < 4; ++ui) { const int qb = (ui == 0) ? 15 - j : (ui == 1) ? 8 + j : (ui == 2) ? 7 - j : j;
                attn_unit(b, h, qb, QB, QB, QW, 192, KN, KPE, VT, lds); }
        }
#endif
    }
    SEAM(7);
    if (IN(8)) {
        pg8::Gemm g{QB, WMO, QW, DM, DM, 0, 1, 384, M / 256, DM / 256};
        pg8::EpiGate2 E{YB, TB, ZG};
        pg8::gemm_phase(lds, g, G, bx, E);
    }
    SEAM(8);
    if (IN(9)) {
        pg8::Gemm g{YB, WOUT, DM, DM, DM, 0, 30, 0, M / 256, DM / 256};
        pg8::EpiSsq E{MMB, SSQ};
        pg8::gemm_phase(lds, g, G, bx, E);
    }
    SEAM(9);
    if (IN(10)) {
        { int it = gw;
          conv_matrix(args.in[20], NGU, DM, NGU, 0, WGU, scr, lane, it, NGW, args.in[18]);
          conv_matrix(args.in[21], DM, DFF, DM, 1, WD, scr, lane, it, NGW); }
        for (int m = gw; m < M; m += NGW) {
            f32x4 v[8], d[8]; ld_row_bf16(D1 + (size_t)m * DM, lane, v);
            ld_row_bf16(MMB + (size_t)m * DM, lane, d);
            const float ss = wave_sum(lane < 32 ? SSQ[(size_t)m * 32 + lane] : 0.f);
            add_normed(v, d, rsqrtf(ss * (1.f / DM) + EPS), args.in[7], lane);
            st_row_bf16(TB + (size_t)m * DM, v, lane);
            const float rstd = rsqrtf(row_ssq(v) * (1.f / DM) + EPS);
            if (lane == 0) RSTD3[m] = rstd;
        }
    }
    SEAM(10);
    if (IN(11)) {
        pg8::Gemm g{TB, WGU, DM, DM, DM, 0, 30, 0, M / 256, NGU / 256};
        pg8::EpiSwiGLU E{ACT, RSTD3};
        pg8::gemm_phase(lds, g, G, bx, E);
    }
    SEAM(11);
    if (IN(12)) {
        pg8::Gemm g{ACT, WD, DFF, DFF, DFF, 0, 30, 0, M / 256, DM / 256};
        pg8::EpiSsq E{D2, SSQ};
        pg8::gemm_phase(lds, g, G, bx, E);
    }
    SEAM(12);
    if (IN(13)) {
        for (int m = gw; m < M; m += NGW) {
            f32x4 v[8], d[8]; ld_row_bf16(TB + (size_t)m * DM, lane, v); ld_row_bf16(D2 + (size_t)m * DM, lane, d);
            const float ss = wave_sum(lane < 32 ? SSQ[(size_t)m * 32 + lane] : 0.f);
            add_normed(v, d, 0.5f * rsqrtf(ss * (1.f / DM) + EPS), args.in[19], lane);
#pragma unroll
            for (int j = 0; j < 8; ++j) *(f32x4*)(out + (size_t)m * DM + 4 * lane + 256 * j) = v[j];
        }
    }
#undef IN
#undef SEAM
#undef vcu
#undef gw
#undef NGW
#undef gt
#undef NGT
#undef scr
#undef COS
#undef SIN
#undef SSQ
#undef SSQC
#undef RSTD1X
#undef RSTD2
#undef RSTD3
#undef RSTDQ
#undef RSTDKV
#undef A1M
#undef ACT1M
#undef D1MP
#undef A2M
#undef ZLOM
#undef KRM
#undef CKVNM
#undef KPE
#undef WIN
#undef WKR
#undef PWS
#undef WPO
#undef WF
#undef WQB
#undef WK
#undef WV
#undef WMO
#undef WOUT
#undef WGU
#undef WD
#undef DPOOL
#undef CQKV
#undef AB
#undef ACT
#undef D1
#undef TB
#undef ZLO
#undef KN
#undef VT
#undef QB
#undef YB
#undef MMB
#undef D2
#undef ZG
}

extern "C" void kernel_launch(void* const* d_in, const int* in_sizes, int n_in, void* d_out, int out_size, void* d_ws, size_t ws_size, hipStream_t stream) {
    static int grid = 0;
    if (grid == 0) {
        if (n_in != 22 || out_size != M * DM || ws_size < WS_END) { fprintf(stderr, "kernel_launch: unexpected shapes (n_in %d out %d ws %zu)\n", n_in, out_size, ws_size); grid = -1; return; }
        int dev = 0, cus = 0, per_cu = 0;
        hipGetDevice(&dev); hipDeviceGetAttribute(&cus, hipDeviceAttributeMultiprocessorCount, dev);
        if (hipFuncSetAttribute((const void*)mk_fwd, hipFuncAttributeMaxDynamicSharedMemorySize, LDS_BYTES) != hipSuccess) { fprintf(stderr, "kernel_launch: hipFuncSetAttribute failed\n"); }
        if (hipOccupancyMaxActiveBlocksPerMultiprocessor(&per_cu, (const void*)mk_fwd, 512, LDS_BYTES) != hipSuccess || per_cu < 1) fprintf(stderr, "kernel_launch: occupancy query says %d\n", per_cu);
        (void)hipGetLastError();
        grid = cus > 0 ? cus : 256;
        if (grid > 256) grid = 256;
        grid -= grid % 8;
    }
    if (grid <= 0) return;
    Args a{};
    for (int i = 0; i < 22; ++i) a.in[i] = (const float*)d_in[i];
    a.out = (float*)d_out; a.ws = (unsigned char*)d_ws;
#if MK_SINGLE
    a.ph_lo = 0; a.ph_hi = NPH; a.coop = 1;
    void* kargs[] = {&a};
    hipError_t e = hipLaunchCooperativeKernel((const void*)mk_fwd, dim3(grid), dim3(512), kargs, LDS_BYTES, stream);
    if (e != hipSuccess) fprintf(stderr, "cooperative launch failed: %s (grid %d)\n", hipGetErrorString(e), grid);
#else
    for (int ph = 0; ph < NPH; ++ph) { a.ph_lo = ph; a.ph_hi = ph + 1; a.coop = 0; hipLaunchKernelGGL(mk_fwd, dim3(grid), dim3(512), LDS_BYTES, stream, a); }
#endif
}
```
